# Optimizing an MI355X kernel written in HIP

```python
import math
import jax, jax.numpy as jnp
from jax import lax
import numpy as np

D_MODEL = 2048
BATCH = 2
SEQ = 4096
DEPTH = 4

N_MIXERS = 4
N_HEADS = 16
HEAD_DIM = D_MODEL // N_HEADS
MLA_HEADS = 16
MLA_Q_LORA = 512
MLA_KV_LORA = 512
MLA_NOPE = 128
MLA_ROPE = 64
MLA_V = 128
ROPE_THETA = 10000.0
HGRN_EXPAND = 128
HGRN_HEADS = D_MODEL // HGRN_EXPAND
HGRN_KDIM = HGRN_EXPAND
HGRN_VDIM = D_MODEL // HGRN_HEADS
HGRN_CHUNK = 64
Q_BLOCK = 128
MOBA_BLOCK = 256
MOBA_TOPK = 3
MOBA_Q_CHUNK = 16
D_FF = 4 * D_MODEL
ALPHA = float((2 * DEPTH) ** 0.25)
BETA = float((8 * DEPTH) ** -0.25)
LN_EPS = 1e-5
RMS_EPS = 1e-6
N_MLA_LAYERS = len(range(0, DEPTH, N_MIXERS))
N_HGRN_LAYERS = len(range(1, DEPTH, N_MIXERS))
N_SB_LAYERS = len(range(2, DEPTH, N_MIXERS))
N_MOBA_LAYERS = len(range(3, DEPTH, N_MIXERS))

kernel_name = "hybrid_mla_hgrn2_stickbreak_moba_deepnorm"

F32 = jnp.float32


def layer_norm(x, g, b):
    xf = x.astype(F32)
    mu = jnp.mean(xf, axis=-1, keepdims=True)
    var = jnp.mean(jnp.square(xf - mu), axis=-1, keepdims=True)
    y = (xf - mu) * lax.rsqrt(var + LN_EPS) * g.astype(F32) + b.astype(F32)
    return y.astype(x.dtype)


def rms_norm(x, g):
    xf = x.astype(F32)
    y = xf * lax.rsqrt(jnp.mean(jnp.square(xf), axis=-1, keepdims=True) + RMS_EPS) * g.astype(F32)
    return y.astype(x.dtype)


def rope_cos_sin(S):
    inv = 1.0 / (ROPE_THETA ** (jnp.arange(0, MLA_ROPE, 2, dtype=F32) / MLA_ROPE))
    ang = jnp.arange(S, dtype=F32)[:, None] * inv[None, :]
    return jnp.cos(ang), jnp.sin(ang)


def apply_rope(x, cos, sin):
    x1, x2 = x[..., : MLA_ROPE // 2], x[..., MLA_ROPE // 2:]
    y = jnp.concatenate([x1 * cos - x2 * sin, x2 * cos + x1 * sin], axis=-1)
    return y.astype(x.dtype)


def causal_softmax_attention(q, k, v, scale):
    B, H, S, dk = q.shape
    nq = S // Q_BLOCK
    qb = q.reshape(B, H, nq, Q_BLOCK, dk).transpose(2, 0, 1, 3, 4)
    key_pos = jnp.arange(S)

    def one_block(args):
        q_blk, i = args
        s = jnp.einsum('bhqd,bhkd->bhqk', q_blk, k).astype(F32) * scale
        q_pos = i * Q_BLOCK + jnp.arange(Q_BLOCK)
        s = jnp.where(key_pos[None, :] <= q_pos[:, None], s, -jnp.inf)
        p = jax.nn.softmax(s, axis=-1).astype(v.dtype)
        return jnp.einsum('bhqk,bhkd->bhqd', p, v)

    o = lax.map(one_block, (qb, jnp.arange(nq)))
    return o.transpose(1, 0, 3, 2, 4).reshape(B, S, H, v.shape[-1])


def mla_mixer(x, w_in, q_norm, kv_norm, w_uq, w_ukv, w_o):
    B, S, _ = x.shape
    h = x @ w_in
    cq = h[..., :MLA_Q_LORA]
    ckv = h[..., MLA_Q_LORA:MLA_Q_LORA + MLA_KV_LORA]
    k_rope = h[..., MLA_Q_LORA + MLA_KV_LORA:]
    cq = rms_norm(cq, q_norm)
    ckv = rms_norm(ckv, kv_norm)
    q = (cq @ w_uq).reshape(B, S, MLA_HEADS, MLA_NOPE + MLA_ROPE)
    kv = (ckv @ w_ukv).reshape(B, S, MLA_HEADS, MLA_NOPE + MLA_V)
    q_nope, q_rope = q[..., :MLA_NOPE], q[..., MLA_NOPE:]
    k_nope, v = kv[..., :MLA_NOPE], kv[..., MLA_NOPE:]
    cos, sin = rope_cos_sin(S)
    q_rope = apply_rope(q_rope, cos[:, None, :], sin[:, None, :])
    k_rope = apply_rope(k_rope, cos, sin)
    k_rope = jnp.broadcast_to(k_rope[:, :, None, :], (B, S, MLA_HEADS, MLA_ROPE))
    q = jnp.concatenate([q_nope, q_rope], axis=-1).transpose(0, 2, 1, 3)
    k = jnp.concatenate([k_nope, k_rope], axis=-1).transpose(0, 2, 1, 3)
    v = v.transpose(0, 2, 1, 3)
    o = causal_softmax_attention(q, k, v, (MLA_NOPE + MLA_ROPE) ** -0.5)
    return o.reshape(B, S, MLA_HEADS * MLA_V) @ w_o


def hgrn2_mixer(x, w_in, lb, o_norm, w_o):
    B, S, D = x.shape
    q, f_pre, i_in, g = jnp.split(x @ w_in, 4, axis=-1)
    lb = lb.astype(F32)
    log_f = jnp.logaddexp(jnp.log(lb), jnp.log1p(-lb) + jax.nn.log_sigmoid(f_pre.astype(F32)))
    k = -jnp.expm1(log_f)
    n = S // HGRN_CHUNK

    def chunks(t, dh):
        return t.astype(F32).reshape(B, n, HGRN_CHUNK, HGRN_HEADS, dh).transpose(1, 0, 3, 2, 4)

    xs = (chunks(q, HGRN_KDIM), chunks(k, HGRN_KDIM), chunks(i_in, HGRN_VDIM), chunks(log_f, HGRN_KDIM))
    causal = jnp.tril(jnp.ones((HGRN_CHUNK, HGRN_CHUNK), dtype=bool))

    def step(state, inp):
        qc, kc, vc, lf = inp
        b = jnp.cumsum(lf, axis=2)
        diff = b[:, :, :, None, :] - b[:, :, None, :, :]
        decay = jnp.exp(jnp.where(causal[:, :, None], diff, -jnp.inf))
        a = jnp.sum(qc[:, :, :, None, :] * kc[:, :, None, :, :] * decay, axis=-1)
        o = (jnp.einsum('bhts,bhsv->bhtv', a, vc)
             + jnp.einsum('bhtd,bhdv->bhtv', qc * jnp.exp(b), state))
        b_end = b[:, :, -1, :]
        state = (jnp.exp(b_end)[..., None] * state
                 + jnp.einsum('bhsd,bhsv->bhdv', kc * jnp.exp(b_end[:, :, None, :] - b), vc))
        return state, o

    state0 = jnp.zeros((B, HGRN_HEADS, HGRN_KDIM, HGRN_VDIM), F32)
    _, o = lax.scan(step, state0, xs)
    o = o.transpose(1, 0, 3, 2, 4).reshape(B, S, HGRN_HEADS, HGRN_VDIM)
    o = rms_norm(o, o_norm.reshape(HGRN_HEADS, HGRN_VDIM))
    o = o.reshape(B, S, D).astype(x.dtype) * jax.nn.silu(g)
    return o @ w_o


def stick_breaking_attention(q, k, v):
    B, H, S, d = q.shape
    scale = d ** -0.5
    nq = S // Q_BLOCK
    qb = q.reshape(B, H, nq, Q_BLOCK, d).transpose(2, 0, 1, 3, 4)
    key_pos = jnp.arange(S)

    def one_block(args):
        q_blk, i = args
        z = jnp.einsum('bhqd,bhkd->bhqk', q_blk, k).astype(F32) * scale
        q_pos = i * Q_BLOCK + jnp.arange(Q_BLOCK)
        strict = key_pos[None, :] < q_pos[:, None]
        log_1m = jnp.where(strict, jax.nn.log_sigmoid(-z), 0.0)
        after = lax.cumsum(log_1m, axis=3, reverse=True) - log_1m
        w = jnp.where(strict, jnp.exp(jax.nn.log_sigmoid(z) + after), 0.0).astype(v.dtype)
        return jnp.einsum('bhqk,bhkd->bhqd', w, v)

    o = lax.map(one_block, (qb, jnp.arange(nq)))
    return o.transpose(1, 0, 3, 2, 4).reshape(B, S, H, d)


def stick_breaking_mixer(x, w_in, w_o):
    B, S, D = x.shape
    q, k, v = jnp.split(x @ w_in, 3, axis=-1)
    heads = lambda t: t.reshape(B, S, N_HEADS, HEAD_DIM).transpose(0, 2, 1, 3)
    o = stick_breaking_attention(heads(q), heads(k), heads(v))
    return o.reshape(B, S, D) @ w_o


def moba_attention(q, k, v):
    B, H, S, d = q.shape
    s_pad = -(-S // MOBA_BLOCK) * MOBA_BLOCK
    pad = ((0, 0), (0, 0), (0, s_pad - S), (0, 0))
    q, k, v = jnp.pad(q, pad), jnp.pad(k, pad), jnp.pad(v, pad)
    nb = s_pad // MOBA_BLOCK
    k_sel = min(MOBA_TOPK, nb)
    scale = d ** -0.5
    k_blocks = k.reshape(B, H, nb, MOBA_BLOCK, d)
    v_blocks = v.reshape(B, H, nb, MOBA_BLOCK, d)
    k_mean = jnp.mean(k_blocks.astype(F32), axis=3)
    gate = jnp.einsum('bhsd,bhnd->bhsn', q.astype(F32), k_mean)
    q_blk = jnp.arange(s_pad) // MOBA_BLOCK
    fully_past = jnp.arange(nb)[None, :] < q_blk[:, None]
    gate = jnp.where(fully_past, gate, -jnp.inf)
    _, sel = lax.top_k(gate, k_sel)
    n_chunks = s_pad // MOBA_Q_CHUNK
    q_c = q.reshape(B, H, n_chunks, MOBA_Q_CHUNK, d).transpose(2, 0, 1, 3, 4)
    sel_c = sel.reshape(B, H, n_chunks, MOBA_Q_CHUNK, k_sel).transpose(2, 0, 1, 3, 4)
    b_idx = jnp.arange(B)[:, None, None, None]
    h_idx = jnp.arange(H)[None, :, None, None]
    n_g = k_sel * MOBA_BLOCK

    def one_chunk(args):
        qb, sb, ci = args
        start = ci * MOBA_Q_CHUNK
        blk = start // MOBA_BLOCK
        q_pos = start + jnp.arange(MOBA_Q_CHUNK)
        k_g = k_blocks[b_idx, h_idx, sb]
        v_g = v_blocks[b_idx, h_idx, sb]
        s_g = jnp.einsum('bhqd,bhqrkd->bhqrk', qb, k_g).astype(F32) * scale
        valid = jnp.arange(k_sel) < blk
        s_g = jnp.where(valid[None, None, None, :, None], s_g, -jnp.inf)
        k_own = lax.dynamic_slice_in_dim(k, blk * MOBA_BLOCK, MOBA_BLOCK, axis=2)
        v_own = lax.dynamic_slice_in_dim(v, blk * MOBA_BLOCK, MOBA_BLOCK, axis=2)
        s_own = jnp.einsum('bhqd,bhkd->bhqk', qb, k_own).astype(F32) * scale
        own_pos = blk * MOBA_BLOCK + jnp.arange(MOBA_BLOCK)
        s_own = jnp.where(own_pos[None, :] <= q_pos[:, None], s_own, -jnp.inf)
        logits = jnp.concatenate([s_g.reshape(B, H, MOBA_Q_CHUNK, n_g), s_own], axis=-1)
        p = jax.nn.softmax(logits, axis=-1).astype(v.dtype)
        p_g = p[..., :n_g].reshape(B, H, MOBA_Q_CHUNK, k_sel, MOBA_BLOCK)
        return (jnp.einsum('bhqrk,bhqrkd->bhqd', p_g, v_g)
                + jnp.einsum('bhqk,bhkd->bhqd', p[..., n_g:], v_own))

    o = lax.map(one_chunk, (q_c, sel_c, jnp.arange(n_chunks)))
    o = o.transpose(1, 0, 3, 2, 4).reshape(B, s_pad, H, d)
    return o[:, :S]


def moba_mixer(x, w_in, w_o):
    B, S, D = x.shape
    q, k, v = jnp.split(x @ w_in, 3, axis=-1)
    heads = lambda t: t.reshape(B, S, N_HEADS, HEAD_DIM).transpose(0, 2, 1, 3)
    o = moba_attention(heads(q), heads(k), heads(v))
    return o.reshape(B, S, D) @ w_o


def sq_relu_mlp(x, w1, w2):
    return jnp.square(jax.nn.relu(x @ w1)) @ w2


def setup_inputs(seed: int = 0) -> dict:
    key = jax.random.key(seed)
    ks = jax.random.split(key, 20)

    def dense(k, shape, fan_in, scale=1.0):
        return jax.random.normal(k, shape, F32) * (scale * fan_in ** -0.5)

    def gain(k, shape):
        return 1.0 + 0.05 * jax.random.normal(k, shape, F32)

    D = D_MODEL
    mla_in_w = MLA_Q_LORA + MLA_KV_LORA + MLA_ROPE
    return {
        "x": jax.random.normal(ks[0], (BATCH, SEQ, D), F32),
        "mla_w_in": dense(ks[1], (N_MLA_LAYERS, D, mla_in_w), D),
        "mla_q_norm": gain(ks[2], (N_MLA_LAYERS, MLA_Q_LORA)),
        "mla_kv_norm": gain(ks[3], (N_MLA_LAYERS, MLA_KV_LORA)),
        "mla_w_uq": dense(ks[4], (N_MLA_LAYERS, MLA_Q_LORA, MLA_HEADS * (MLA_NOPE + MLA_ROPE)), MLA_Q_LORA),
        "mla_w_ukv": dense(ks[5], (N_MLA_LAYERS, MLA_KV_LORA, MLA_HEADS * (MLA_NOPE + MLA_V)), MLA_KV_LORA),
        "mla_w_o": dense(ks[6], (N_MLA_LAYERS, MLA_HEADS * MLA_V, D), MLA_HEADS * MLA_V, BETA),
        "hgrn_w_in": dense(ks[7], (N_HGRN_LAYERS, D, 4 * D), D),
        "hgrn_lb_logits": 0.1 * jax.random.normal(ks[8], (DEPTH, D), F32),
        "hgrn_o_norm": gain(ks[9], (N_HGRN_LAYERS, D)),
        "hgrn_w_o": dense(ks[10], (N_HGRN_LAYERS, D, D), D, BETA),
        "sb_w_in": dense(ks[11], (N_SB_LAYERS, D, 3 * D), D),
        "sb_w_o": dense(ks[12], (N_SB_LAYERS, D, D), D, BETA),
        "moba_w_in": dense(ks[13], (N_MOBA_LAYERS, D, 3 * D), D),
        "moba_w_o": dense(ks[14], (N_MOBA_LAYERS, D, D), D, BETA),
        "ln_g": gain(ks[15], (DEPTH, 2, D)),
        "ln_b": 0.02 * jax.random.normal(ks[16], (DEPTH, 2, D), F32),
        "mlp_w1": dense(ks[17], (DEPTH, D, D_FF), D),
        "mlp_w2": dense(ks[18], (DEPTH, D_FF, D), D_FF, BETA),
    }


def reference(x, mla_w_in, mla_q_norm, mla_kv_norm, mla_w_uq, mla_w_ukv, mla_w_o,
              hgrn_w_in, hgrn_lb_logits, hgrn_o_norm, hgrn_w_o,
              sb_w_in, sb_w_o, moba_w_in, moba_w_o,
              ln_g, ln_b, mlp_w1, mlp_w2):
    lb_p = jax.nn.softmax(hgrn_lb_logits.astype(F32), axis=0)
    lower_bounds = jnp.cumsum(lb_p, axis=0) - lb_p[0]
    h = x
    for i in range(DEPTH):
        kind, slot = i % N_MIXERS, i // N_MIXERS
        if kind == 0:
            y = mla_mixer(h, mla_w_in[slot], mla_q_norm[slot], mla_kv_norm[slot],
                          mla_w_uq[slot], mla_w_ukv[slot], mla_w_o[slot])
        elif kind == 1:
            y = hgrn2_mixer(h, hgrn_w_in[slot], lower_bounds[i], hgrn_o_norm[slot], hgrn_w_o[slot])
        elif kind == 2:
            y = stick_breaking_mixer(h, sb_w_in[slot], sb_w_o[slot])
        else:
            y = moba_mixer(h, moba_w_in[slot], moba_w_o[slot])
        h = layer_norm(ALPHA * h + y, ln_g[i, 0], ln_b[i, 0])
        h = layer_norm(ALPHA * h + sq_relu_mlp(h, mlp_w1[i], mlp_w2[i]), ln_g[i, 1], ln_b[i, 1])
    return h
```

```cpp
#include <hip/hip_runtime.h>
#include <hip/hip_cooperative_groups.h>
#include <cstdio>
#include <cstdint>
namespace cg = cooperative_groups;

namespace pg8 {
#define PG8_LAS __attribute__((address_space(3)))
typedef unsigned short bf16_t;
typedef short bf16x8 __attribute__((ext_vector_type(8)));
typedef float f32x4 __attribute__((ext_vector_type(4)));
typedef unsigned u32x4 __attribute__((ext_vector_type(4)));
constexpr int BM = 256, BK = 64, HALF = 128, HTB = HALF * BK * 2  , STAGE_BYTES = 8 * HTB, NXCD = 8, WGM = 8;

__host__ __device__ __forceinline__ int lds_byte(int r, int c) { const int st = (r >> 4) * 2 + (c >> 5), rr = r & 15, cc = c & 31, ob = rr * 64 + cc * 2; return st * 1024 + (ob ^ (((ob >> 9) & 1) << 5)); }
__host__ __device__ __forceinline__ void stage_rc(int b, int& R, int& C) { const int st = b / 1024, sb = b % 1024, swz = sb ^ (((sb >> 9) & 1) << 5); R = (st >> 1) * 16 + swz / 64; C = (st & 1) * 32 + (swz % 64) / 2; }
__host__ __device__ __forceinline__ int perm32(int rho) { const int n = rho >> 4, i = rho & 15; return 8 * (i >> 2) + 4 * n + (i & 3); }

struct Unit { int pm, pn; };
struct Gemm { const bf16_t* A; const bf16_t* Bt; int M, N, K; };

struct StaticOrder {
    int nM, nN, nwg, G, c;
    __host__ __device__ void init(int M, int N, int G_, int c_) { nM = M / BM; nN = N / BM; nwg = nM * nN; G = G_; c = c_; }
    __host__ __device__ bool next(int i, Unit& u) const {
        const long L = (long)i * G + c; if (L >= nwg) return false;
        int wgid = (int)L; { const int q = nwg / NXCD, r = nwg % NXCD, xcd = wgid % NXCD, off = wgid / NXCD; wgid = (xcd < r ? xcd * (q + 1) : r * (q + 1) + (xcd - r) * q) + off; }
        const int nig = WGM * nN, gid = wgid / nig, fm = gid * WGM, gsz = (nM - fm) < WGM ? (nM - fm) : WGM;
        u.pm = fm + ((wgid % nig) % gsz); u.pn = (wgid % nig) / gsz; return true;
    }
    __device__ __forceinline__ void a_ready(const Unit&) const {}
    __device__ __forceinline__ void done(const Unit&) const {}
};

typedef float f32x2 __attribute__((ext_vector_type(2)));
typedef __bf16 bf16x2_t __attribute__((ext_vector_type(2)));
__device__ __forceinline__ unsigned cvtpk(float lo, float hi) { f32x2 v = {lo, hi}; bf16x2_t b = __builtin_convertvector(v, bf16x2_t); return __builtin_bit_cast(unsigned, b); }

struct EpiStore {
    static constexpr bool PERM = true, AFTER_DRAIN = false;
    bf16_t* O; int ldc; float scale; int act;
    bf16_t* O2; int split_col; int ldc2; float scale2;
    const float* rope; int rope_col;
    __device__ __forceinline__ void operator()(const f32x4 (&acc)[2][2][4][2], const Unit& u, int wr, int wc, int fr, int fq) const {
        const int row0 = u.pm * BM + wr * 64 + fr; int colt = u.pn * BM; bf16_t* base = O; int ld = ldc; float sc = scale;
        const bool do_rope = (rope != nullptr) && (colt >= rope_col);
        if (colt >= split_col) { base = O2; ld = ldc2; sc = scale2; colt -= split_col; }
        const int col0 = colt + wc * 32 + 8 * fq;
#pragma unroll
        for (int ai = 0; ai < 2; ++ai)
#pragma unroll
            for (int m = 0; m < 4; ++m) { const int row = row0 + ai * HALF + m * 16; bf16_t* rowp = base + (size_t)row * ld + col0;
#pragma unroll
                for (int bj = 0; bj < 2; ++bj) { f32x4 v0 = acc[ai][bj][m][0], v1 = acc[ai][bj][m][1];
                    if (act == 1) {
#pragma unroll
                        for (int e = 0; e < 4; ++e) { float a = fmaxf(v0[e], 0.f), b = fmaxf(v1[e], 0.f); v0[e] = a * a; v1[e] = b * b; } }
                    if (do_rope) { const int gc = u.pn * BM + bj * HALF + wc * 32 + 8 * fq - rope_col; const int i0 = (gc & 63) >> 1; const int pos = row & 4095;
                        const f32x4 t0 = *(const f32x4*)(rope + ((size_t)pos * 32 + i0) * 2), t1 = *(const f32x4*)(rope + ((size_t)pos * 32 + i0 + 2) * 2);
                        f32x4 w0, w1;
                        w0[0] = v0[0] * t0[0] - v0[1] * t0[1]; w0[1] = v0[1] * t0[0] + v0[0] * t0[1];
                        w0[2] = v0[2] * t0[2] - v0[3] * t0[3]; w0[3] = v0[3] * t0[2] + v0[2] * t0[3];
                        w1[0] = v1[0] * t1[0] - v1[1] * t1[1]; w1[1] = v1[1] * t1[0] + v1[0] * t1[1];
                        w1[2] = v1[2] * t1[2] - v1[3] * t1[3]; w1[3] = v1[3] * t1[2] + v1[2] * t1[3];
                        v0 = w0; v1 = w1; }
                    v0 = v0 * sc; v1 = v1 * sc; u32x4 w; w.x = cvtpk(v0[0], v0[1]); w.y = cvtpk(v0[2], v0[3]); w.z = cvtpk(v1[0], v1[1]); w.w = cvtpk(v1[2], v1[3]);
                    *(u32x4*)(rowp + bj * HALF) = w; } }
    }
};
struct EpiRes {
    static constexpr bool PERM = false, AFTER_DRAIN = false;
    const float* hin; float* z; int ldc; float alpha;
    __device__ __forceinline__ void operator()(const f32x4 (&acc)[2][2][4][2], const Unit& u, int wr, int wc, int fr, int fq) const {
        const int row0 = u.pm * BM + wr * 64 + fr, col0 = u.pn * BM + wc * 32 + 4 * fq;
#pragma unroll
        for (int ai = 0; ai < 2; ++ai)
#pragma unroll
            for (int m = 0; m < 4; ++m) { const size_t off = (size_t)(row0 + ai * HALF + m * 16) * ldc + col0;
#pragma unroll
                for (int bj = 0; bj < 2; ++bj)
#pragma unroll
                    for (int n = 0; n < 2; ++n) { const f32x4 h4 = *(const f32x4*)(hin + off + bj * HALF + n * 16); *(f32x4*)(z + off + bj * HALF + n * 16) = h4 * alpha + acc[ai][bj][m][n]; } }
    }
};
template <class Epi, class Sched, bool ALIGN_EPI = false, bool SP2 = false>
__device__ __forceinline__ void gemm_phase(PG8_LAS unsigned char* lds, const Gemm g, const Sched& S, const Epi& E) {
    const int tid = threadIdx.x, wid = __builtin_amdgcn_readfirstlane(tid >> 6), lane = tid & 63, wr = wid >> 2, wc = wid & 3, fr = lane & 15, fq = lane >> 4;
    const int K = g.K, nt = K / BK;
    unsigned voffA[2], voffB[2];
#pragma unroll
    for (int i = 0; i < 2; ++i) { int R, C; stage_rc(tid * 16 + i * 8192, R, C); const int Rb = Epi::PERM ? ((R & ~31) + perm32(R & 31)) : R;
        voffA[i] = (unsigned)(R * K + C) * 2u; voffB[i] = (unsigned)(Rb * K + C) * 2u; }
    const size_t kstep = (size_t)(BK * 2);
    const size_t hstep = (size_t)HALF * K * 2;
    const size_t tstep = 2 * hstep;
    const unsigned ldsw = (unsigned)wid * 1024u;
    const int aoff = lds_byte(wr * 64 + fr, fq * 8), boff = lds_byte(wc * 32 + fr, fq * 8);
#define PG8_SA(b, h) (((b) * 2 + (h)) * HTB)
#define PG8_SB(b, h) ((4 + (b) * 2 + (h)) * HTB)
#define PG8_STAGE(bufoff, gbase, voff) do { _Pragma("unroll") for (int _i = 0; _i < 2; ++_i) \
        __builtin_amdgcn_global_load_lds((const unsigned*)((const char*)(gbase) + (voff)[_i]), (PG8_LAS unsigned*)(lds + (bufoff) + ldsw + _i * 8192), 16, 0, 0); } while (0)
#define PG8_LDA(dst, b, h) do { _Pragma("unroll") for (int m = 0; m < 4; ++m) _Pragma("unroll") for (int k = 0; k < 2; ++k) dst[m][k] = *(const PG8_LAS bf16x8*)(lds + PG8_SA(b, h) + aoff + m * 2048 + k * 1024); } while (0)
#define PG8_LDB(dst, b, h) do { _Pragma("unroll") for (int n = 0; n < 2; ++n) _Pragma("unroll") for (int k = 0; k < 2; ++k) dst[n][k] = *(const PG8_LAS bf16x8*)(lds + PG8_SB(b, h) + boff + n * 2048 + k * 1024); } while (0)
#define PG8_MMA(ai, bj, At, Bt) do { __builtin_amdgcn_s_setprio(1); _Pragma("unroll") for (int m = 0; m < 4; ++m) _Pragma("unroll") for (int n = 0; n < 2; ++n) _Pragma("unroll") for (int k = 0; k < 2; ++k) \
        acc[ai][bj][m][n] = __builtin_amdgcn_mfma_f32_16x16x32_bf16(Bt[n][k], At[m][k], acc[ai][bj][m][n], 0, 0, 0); __builtin_amdgcn_s_setprio(0); } while (0)
#define PG8_WAIT_V(n) asm volatile("s_waitcnt vmcnt(" #n ")" ::: "memory")
#define PG8_WAIT_L(n) asm volatile("s_waitcnt lgkmcnt(" #n ")" ::: "memory")
#define PG8_BAR __builtin_amdgcn_s_barrier()
#define PG8_SCHED __builtin_amdgcn_sched_barrier(0)
    Unit cur, nxt; int ui = 0;
    if (!S.next(0, cur)) return;
    f32x4 acc[2][2][4][2];
#pragma unroll
    for (int a = 0; a < 2; ++a)
#pragma unroll
        for (int b = 0; b < 2; ++b)
#pragma unroll
            for (int m = 0; m < 4; ++m)
#pragma unroll
                for (int n = 0; n < 2; ++n) acc[a][b][m][n] = (f32x4){0.f, 0.f, 0.f, 0.f};
    bf16x8 At[4][2], B0[2][2], B1[2][2];
    const char* cA = (const char*)g.A + (size_t)cur.pm * tstep; const char* cB = (const char*)g.Bt + (size_t)cur.pn * tstep;
    S.a_ready(cur);
    if constexpr (SP2) {
        PG8_STAGE(PG8_SB(0, 0), cB, voffB); PG8_STAGE(PG8_SB(0, 1), cB + hstep, voffB); PG8_STAGE(PG8_SA(0, 0), cA, voffA); PG8_STAGE(PG8_SA(0, 1), cA + hstep, voffA);
        if (wr == 1) PG8_BAR;
        PG8_WAIT_V(2); PG8_BAR;
        PG8_STAGE(PG8_SB(1, 0), cB + kstep, voffB); PG8_STAGE(PG8_SA(1, 0), cA + kstep, voffA); PG8_STAGE(PG8_SB(1, 1), cB + hstep + kstep, voffB);
        PG8_WAIT_V(6); PG8_BAR;
    } else {
        PG8_STAGE(PG8_SB(0, 0), cB, voffB); PG8_STAGE(PG8_SA(0, 0), cA, voffA); PG8_STAGE(PG8_SB(0, 1), cB + hstep, voffB); PG8_STAGE(PG8_SA(0, 1), cA + hstep, voffA);
        if (wr == 1) PG8_BAR;
        PG8_WAIT_V(4); PG8_BAR;
        PG8_STAGE(PG8_SB(1, 0), cB + kstep, voffB); PG8_STAGE(PG8_SA(1, 0), cA + kstep, voffA); PG8_STAGE(PG8_SB(1, 1), cB + hstep + kstep, voffB);
        PG8_WAIT_V(6); PG8_BAR;
    }
    for (;;) {
        const bool has_next = S.next(ui + 1, nxt);
        const char* nA = has_next ? (const char*)g.A + (size_t)nxt.pm * tstep : cA; const char* nB = has_next ? (const char*)g.Bt + (size_t)nxt.pn * tstep : cB;
        for (int t = 0; t < nt; t += 2) {
            const bool last = (t == nt - 2);
            const char* a1 = cA + (size_t)(t + 1) * kstep;
            const char* a2 = last ? nA : cA + (size_t)(t + 2) * kstep; const char* b2 = last ? nB : cB + (size_t)(t + 2) * kstep;
            const char* a3 = a2 + kstep; const char* b3 = b2 + kstep;
            if (last && has_next) S.a_ready(nxt);
            if constexpr (SP2) {
            PG8_LDB(B0, 0, 0); PG8_LDB(B1, 0, 1); PG8_SCHED; PG8_LDA(At, 0, 0); PG8_STAGE(PG8_SA(1, 1), a1 + hstep, voffA);
            PG8_WAIT_V(8); PG8_WAIT_L(0); PG8_BAR; PG8_MMA(0, 0, At, B0); PG8_MMA(0, 1, At, B1); PG8_BAR; PG8_SCHED;
            PG8_LDA(At, 0, 1); PG8_STAGE(PG8_SB(0, 0), b2, voffB); PG8_STAGE(PG8_SB(0, 1), b2 + hstep, voffB); PG8_STAGE(PG8_SA(0, 0), a2, voffA);
            PG8_WAIT_V(8); PG8_WAIT_L(0); PG8_BAR; PG8_MMA(1, 0, At, B0); PG8_MMA(1, 1, At, B1); PG8_BAR; PG8_SCHED;
            PG8_LDB(B0, 1, 0); PG8_LDB(B1, 1, 1); PG8_SCHED; PG8_LDA(At, 1, 0); PG8_STAGE(PG8_SA(0, 1), a2 + hstep, voffA);
            PG8_WAIT_V(8); PG8_WAIT_L(0); PG8_BAR; PG8_MMA(0, 0, At, B0); PG8_MMA(0, 1, At, B1); PG8_BAR; PG8_SCHED;
            PG8_LDA(At, 1, 1); PG8_STAGE(PG8_SB(1, 0), b3, voffB); PG8_STAGE(PG8_SB(1, 1), b3 + hstep, voffB); PG8_STAGE(PG8_SA(1, 0), a3, voffA);
            PG8_WAIT_V(8); PG8_WAIT_L(0); PG8_BAR; PG8_MMA(1, 0, At, B0); PG8_MMA(1, 1, At, B1); PG8_BAR; PG8_SCHED;
            } else {
            PG8_LDB(B0, 0, 0); PG8_SCHED; PG8_LDA(At, 0, 0); PG8_STAGE(PG8_SA(1, 1), a1 + hstep, voffA);
            PG8_WAIT_L(8); PG8_BAR; PG8_WAIT_L(0); PG8_MMA(0, 0, At, B0); PG8_BAR; PG8_SCHED;
            PG8_LDB(B1, 0, 1); PG8_STAGE(PG8_SB(0, 0), b2, voffB);
            PG8_BAR; PG8_WAIT_L(0); PG8_MMA(0, 1, At, B1); PG8_BAR;
            PG8_LDA(At, 0, 1); PG8_STAGE(PG8_SA(0, 0), a2, voffA);
            PG8_BAR; PG8_WAIT_L(0); PG8_MMA(1, 0, At, B0); PG8_BAR; PG8_SCHED;
            PG8_STAGE(PG8_SB(0, 1), b2 + hstep, voffB);
            PG8_WAIT_V(6); PG8_BAR; PG8_MMA(1, 1, At, B1); PG8_BAR;
            PG8_LDB(B0, 1, 0); PG8_SCHED; PG8_LDA(At, 1, 0); PG8_STAGE(PG8_SA(0, 1), a2 + hstep, voffA);
            PG8_WAIT_L(8); PG8_BAR; PG8_WAIT_L(0); PG8_MMA(0, 0, At, B0); PG8_BAR; PG8_SCHED;
            PG8_LDB(B1, 1, 1); PG8_STAGE(PG8_SB(1, 0), b3, voffB);
            PG8_BAR; PG8_WAIT_L(0); PG8_MMA(0, 1, At, B1); PG8_BAR;
            PG8_LDA(At, 1, 1); PG8_STAGE(PG8_SA(1, 0), a3, voffA);
            PG8_BAR; PG8_WAIT_L(0); PG8_MMA(1, 0, At, B0); PG8_BAR; PG8_SCHED;
            PG8_STAGE(PG8_SB(1, 1), b3 + hstep, voffB);
            PG8_WAIT_V(6); PG8_BAR; PG8_MMA(1, 1, At, B1); PG8_BAR;
            }
        }
        if constexpr (ALIGN_EPI) { if (wr == 0) PG8_BAR; }
        if constexpr (!Epi::AFTER_DRAIN) { E(acc, cur, wr, wc, fr, fq); S.done(cur); }
        if (!has_next) break;
#pragma unroll
        for (int a = 0; a < 2; ++a)
#pragma unroll
            for (int b = 0; b < 2; ++b)
#pragma unroll
                for (int m = 0; m < 4; ++m)
#pragma unroll
                    for (int n = 0; n < 2; ++n) acc[a][b][m][n] = (f32x4){0.f, 0.f, 0.f, 0.f};
        cur = nxt; cA = nA; cB = nB; ++ui;
        if constexpr (ALIGN_EPI) { if (wr == 1) PG8_BAR; }
    }
    PG8_WAIT_V(0);
    if constexpr (!ALIGN_EPI) { if (wr == 0) PG8_BAR; }
    PG8_BAR;
    if constexpr (Epi::AFTER_DRAIN) { E.fused(acc, cur, wr, wc, fr, fq, lds, wid, lane); S.done(cur); }
#undef PG8_SA
#undef PG8_SB
#undef PG8_STAGE
#undef PG8_LDA
#undef PG8_LDB
#undef PG8_MMA
#undef PG8_WAIT_V
#undef PG8_WAIT_L
#undef PG8_BAR
#undef PG8_SCHED
}
}

#define LAS __attribute__((address_space(3)))
typedef unsigned short bf16_t;
typedef float f32x4 __attribute__((ext_vector_type(4)));
typedef float f32x16 __attribute__((ext_vector_type(16)));
typedef short bf16x8 __attribute__((ext_vector_type(8)));
typedef short s16x4 __attribute__((ext_vector_type(4)));
typedef unsigned u32x4 __attribute__((ext_vector_type(4)));
typedef unsigned u32x2 __attribute__((ext_vector_type(2)));
using pg8::cvtpk;
#define MFMA32(a, b, c) __builtin_amdgcn_mfma_f32_32x32x16_bf16((a), (b), (c), 0, 0, 0)

constexpr int T = 8192, SEQ = 4096, D = 2048, FF = 8192, NH = 16;
constexpr float ALPHA = 1.681792830507429f;
constexpr float LN_EPS = 1e-5f, RMS_EPS = 1e-6f;
constexpr float LOG2E = 1.4426950408889634f;

constexpr size_t MiB = 1u << 20;
constexpr size_t WS_ROPE = 1 * MiB, WS_LB = 2 * MiB, WS_KMEAN = 3 * MiB;
constexpr size_t WS_W_MLAIN = 4 * MiB, WS_W_UQ = 9 * MiB, WS_W_UK = 12 * MiB, WS_W_UV = 14 * MiB, WS_W_MLAO = 16 * MiB;
constexpr size_t WS_W_HGIN = 24 * MiB, WS_W_HGO = 56 * MiB, WS_W_SBIN = 64 * MiB, WS_W_SBO = 88 * MiB, WS_W_MBIN = 96 * MiB, WS_W_MBO = 120 * MiB;
constexpr size_t WS_W1 = 128 * MiB, WS_W2 = 256 * MiB;
constexpr size_t WS_H32 = 384 * MiB, WS_HB = 448 * MiB, WS_BIG = 480 * MiB, WS_MIX = 608 * MiB;
constexpr size_t WS_H0 = WS_MIX, WS_CQN = WS_MIX + 20 * MiB, WS_CKVN = WS_MIX + 28 * MiB, WS_KR = WS_MIX + 36 * MiB, WS_Q3 = WS_MIX + 40 * MiB, WS_KN = WS_MIX + 88 * MiB, WS_VT = WS_MIX + 120 * MiB, WS_O = WS_MIX + 152 * MiB;
constexpr size_t WS_Q = WS_MIX, WS_K = WS_MIX + 32 * MiB;
constexpr size_t WS_QT = WS_MIX, WS_OI = WS_MIX + 32 * MiB, WS_DELTA = WS_MIX + 96 * MiB, WS_DEC = WS_MIX + 160 * MiB, WS_GO = WS_MIX + 162 * MiB;
constexpr size_t WS_END = WS_MIX + 200 * MiB;
static_assert(WS_END <= 1024 * MiB, "workspace");

constexpr int LDS_BYTES = 155648;
constexpr int NWAVES = 8;

__device__ __forceinline__ float bflo(unsigned u) { return __uint_as_float(u << 16); }
__device__ __forceinline__ float bfhi(unsigned u) { return __uint_as_float(u & 0xffff0000u); }
__device__ __forceinline__ float bf2f(unsigned short b) { return __uint_as_float(((unsigned)b) << 16); }
__device__ __forceinline__ unsigned short f2bf(float f) { return (unsigned short)(cvtpk(f, 0.f) & 0xffffu); }
__device__ __forceinline__ float wave_sum(float v) {
#pragma unroll
    for (int o = 1; o < 64; o <<= 1) v += __shfl_xor(v, o);
    return v;
}
__device__ __forceinline__ float xhalf(float v) {
    auto rr = __builtin_amdgcn_permlane32_swap(__float_as_uint(v), __float_as_uint(v), false, false);
    return __uint_as_float((threadIdx.x & 32) ? rr[0] : rr[1]);
}
__device__ __forceinline__ int crow(int r, int hi) { return (r & 3) + 8 * (r >> 2) + 4 * hi; }

struct Params { const float* in[19]; float* out; unsigned char* ws; int ph_lo, ph_hi; };

__device__ __forceinline__ int srccol(int mode, int n) {
    if (mode == 0) return n;
    if (mode == 1) { if (n < 2048) return (n >> 7) * 192 + (n & 127); const int r = n - 2048, h = r >> 6, q = r & 63; return h * 192 + 128 + (q >> 1) + 32 * (q & 1); }
    if (mode == 2) return (n >> 7) * 256 + (n & 127);
    if (mode == 3) return (n >> 7) * 256 + 128 + (n & 127);
    if (n < 1024) return n;
    if (n < 1088) { const int r = n - 1024; return 1024 + (r >> 1) + 32 * (r & 1); }
    return -1;
}
__device__ __forceinline__ void tr_job(const float* W, int K, int Nsrc, int Ndst, bf16_t* WT, int mode, LAS float* scr, int gw, int NGW, int lane) {
    const int nblk = Ndst / 32, nitems = (K / 64) * nblk;
    for (int it = gw; it < nitems; it += NGW) {
        const int kb = it / nblk, nb = it % nblk, k0 = 64 * kb, n0 = 32 * nb;
        const int sc = srccol(mode, n0 + (lane & 31));
#pragma unroll 8
        for (int i = 0; i < 32; ++i) { const int kk = 2 * i + (lane >> 5); scr[kk * 33 + (lane & 31)] = sc >= 0 ? W[(size_t)(k0 + kk) * Nsrc + sc] : 0.f; }
        asm volatile("s_waitcnt lgkmcnt(0)" ::: "memory");
        const int c = lane & 7;
#pragma unroll
        for (int j = 0; j < 4; ++j) { const int n = (lane >> 3) + 8 * j; const LAS float* s = scr + (8 * c) * 33 + n;
            u32x4 o; o.x = cvtpk(s[0 * 33], s[1 * 33]); o.y = cvtpk(s[2 * 33], s[3 * 33]); o.z = cvtpk(s[4 * 33], s[5 * 33]); o.w = cvtpk(s[6 * 33], s[7 * 33]);
            *(u32x4*)(WT + (size_t)(n0 + n) * K + k0 + 8 * c) = o; }
        asm volatile("s_waitcnt lgkmcnt(0)" ::: "memory");
    }
}

__device__ __forceinline__ void phase_prologue(const Params& p, LAS unsigned char* lds, int vcu, int G) {
    const int tid = threadIdx.x, lane = tid & 63, wave = tid >> 6;
    const int gw = vcu * NWAVES + wave, NGW = G * NWAVES;
    LAS float* scr = (LAS float*)(lds + wave * 8704);
    unsigned char* ws = p.ws;
    tr_job(p.in[1], 2048, 1088, 1280, (bf16_t*)(ws + WS_W_MLAIN), 4, scr, gw, NGW, lane);
    tr_job(p.in[4], 512, 3072, 3072, (bf16_t*)(ws + WS_W_UQ), 1, scr, gw, NGW, lane);
    tr_job(p.in[5], 512, 4096, 2048, (bf16_t*)(ws + WS_W_UK), 2, scr, gw, NGW, lane);
    tr_job(p.in[5], 512, 4096, 2048, (bf16_t*)(ws + WS_W_UV), 3, scr, gw, NGW, lane);
    tr_job(p.in[6], 2048, 2048, 2048, (bf16_t*)(ws + WS_W_MLAO), 0, scr, gw, NGW, lane);
    tr_job(p.in[7], 2048, 8192, 8192, (bf16_t*)(ws + WS_W_HGIN), 0, scr, gw, NGW, lane);
    tr_job(p.in[10], 2048, 2048, 2048, (bf16_t*)(ws + WS_W_HGO), 0, scr, gw, NGW, lane);
    tr_job(p.in[11], 2048, 6144, 6144, (bf16_t*)(ws + WS_W_SBIN), 0, scr, gw, NGW, lane);
    tr_job(p.in[12], 2048, 2048, 2048, (bf16_t*)(ws + WS_W_SBO), 0, scr, gw, NGW, lane);
    tr_job(p.in[13], 2048, 6144, 6144, (bf16_t*)(ws + WS_W_MBIN), 0, scr, gw, NGW, lane);
    tr_job(p.in[14], 2048, 2048, 2048, (bf16_t*)(ws + WS_W_MBO), 0, scr, gw, NGW, lane);
    for (int l = 0; l < 4; ++l) {
        tr_job(p.in[17] + (size_t)l * D * FF, D, FF, FF, (bf16_t*)(ws + WS_W1) + (size_t)l * D * FF, 0, scr, gw, NGW, lane);
        tr_job(p.in[18] + (size_t)l * D * FF, FF, D, D, (bf16_t*)(ws + WS_W2) + (size_t)l * D * FF, 0, scr, gw, NGW, lane);
    }
    { const f32x4* x4 = (const f32x4*)p.in[0]; u32x2* hb = (u32x2*)(ws + WS_HB); const int gt = vcu * 512 + tid, NT = G * 512;
      for (int i = gt; i < T * D / 4; i += NT) { const f32x4 v = x4[i]; u32x2 o; o.x = cvtpk(v[0], v[1]); o.y = cvtpk(v[2], v[3]); hb[i] = o; } }
    { float* rt = (float*)(ws + WS_ROPE); const int gt = vcu * 512 + tid, NT = G * 512;
      for (int e = gt; e < SEQ * 32; e += NT) { const int pos = e >> 5, i = e & 31;
          const float inv = 1.0f / exp2f((float)i * (13.287712379549449f / 32.0f));
          const float ang = (float)pos * inv;
          const double rev = (double)ang * 0.15915494309189535; const float fr = (float)(rev - floor(rev));
          rt[2 * e] = __builtin_amdgcn_cosf(fr); rt[2 * e + 1] = __builtin_amdgcn_sinf(fr); } }
    { float* lb = (float*)(ws + WS_LB); const float* lg = p.in[8]; const int gt = vcu * 512 + tid;
      if (gt < D) { const float a0 = lg[gt], a1 = lg[D + gt], a2 = lg[2 * D + gt], a3 = lg[3 * D + gt]; const float mx = fmaxf(fmaxf(a0, a1), fmaxf(a2, a3));
          const float e0 = expf(a0 - mx), e1 = expf(a1 - mx), e2 = expf(a2 - mx), e3 = expf(a3 - mx); lb[gt] = e1 / (e0 + e1 + e2 + e3); } }
}

__device__ __forceinline__ void phase_ln(const float* Z, const float* g, const float* bt, float* H, bf16_t* HB, int vcu, int G) {
    const int tid = threadIdx.x, lane = tid & 63, wave = tid >> 6; const int gw = vcu * NWAVES + wave, NGW = G * NWAVES;
    for (int m = gw; m < T; m += NGW) {
        const f32x4* zr = (const f32x4*)(Z + (size_t)m * D) + lane; f32x4 v[8]; float s = 0.f;
#pragma unroll
        for (int j = 0; j < 8; ++j) { v[j] = zr[64 * j]; s += (v[j][0] + v[j][1]) + (v[j][2] + v[j][3]); }
        const float mean = wave_sum(s) * (1.f / D); float s2 = 0.f;
#pragma unroll
        for (int j = 0; j < 8; ++j) { v[j] = v[j] - mean; s2 += (v[j][0] * v[j][0] + v[j][1] * v[j][1]) + (v[j][2] * v[j][2] + v[j][3] * v[j][3]); }
        const float rstd = 1.f / sqrtf(wave_sum(s2) * (1.f / D) + LN_EPS);
        f32x4* hr = (f32x4*)(H + (size_t)m * D) + lane; u32x2* br = HB ? (u32x2*)(HB + (size_t)m * D) + lane : nullptr;
#pragma unroll
        for (int j = 0; j < 8; ++j) { const f32x4 gg = ((const f32x4*)g)[lane + 64 * j], bb = ((const f32x4*)bt)[lane + 64 * j]; const f32x4 y = v[j] * rstd * gg + bb;
            hr[64 * j] = y; if (br) { u32x2 o; o.x = cvtpk(y[0], y[1]); o.y = cvtpk(y[2], y[3]); br[64 * j] = o; } }
    }
}
__device__ __forceinline__ void phase_mla_prep(const bf16_t* H0, const float* qn, const float* kvn, const float* rope, bf16_t* CQN, bf16_t* CKVN, bf16_t* KR, int vcu, int G) {
    const int tid = threadIdx.x, lane = tid & 63, wave = tid >> 6; const int gw = vcu * NWAVES + wave, NGW = G * NWAVES;
    for (int m = gw; m < T; m += NGW) {
        const bf16_t* row = H0 + (size_t)m * 1280;
#pragma unroll
        for (int part = 0; part < 2; ++part) {
            const u32x4 raw = *(const u32x4*)(row + part * 512 + 8 * lane);
            float v[8]; v[0] = bflo(raw.x); v[1] = bfhi(raw.x); v[2] = bflo(raw.y); v[3] = bfhi(raw.y); v[4] = bflo(raw.z); v[5] = bfhi(raw.z); v[6] = bflo(raw.w); v[7] = bfhi(raw.w);
            float ss = 0.f;
#pragma unroll
            for (int j = 0; j < 8; ++j) ss += v[j] * v[j];
            const float r = 1.f / sqrtf(wave_sum(ss) * (1.f / 512.f) + RMS_EPS);
            const float* gp = (part ? kvn : qn) + 8 * lane; const f32x4 g0 = *(const f32x4*)gp, g1 = *(const f32x4*)(gp + 4);
            u32x4 o; o.x = cvtpk(v[0] * r * g0[0], v[1] * r * g0[1]); o.y = cvtpk(v[2] * r * g0[2], v[3] * r * g0[3]); o.z = cvtpk(v[4] * r * g1[0], v[5] * r * g1[1]); o.w = cvtpk(v[6] * r * g1[2], v[7] * r * g1[3]);
            *(u32x4*)((part ? CKVN : CQN) + (size_t)m * 512 + 8 * lane) = o;
        }
        if (lane < 32) { const unsigned raw = *(const unsigned*)(row + 1024 + 2 * lane); const float x1 = bflo(raw), x2 = bfhi(raw); const int pos = m & (SEQ - 1);
            const float c = rope[((size_t)pos * 32 + lane) * 2], s = rope[((size_t)pos * 32 + lane) * 2 + 1];
            *(unsigned*)(KR + (size_t)m * 64 + 2 * lane) = cvtpk(x1 * c - x2 * s, x2 * c + x1 * s); }
    }
}
__device__ __forceinline__ void phase_kmean(const bf16_t* K, float* KM, LAS unsigned char* lds, int vcu, int G) {
    const int tid = threadIdx.x; LAS float* red = (LAS float*)lds;
    for (int u = vcu; u < 512; u += G) { const int bh = u >> 4, blk = u & 15, b = bh >> 4, h = bh & 15;
        const int d = tid & 127, part = tid >> 7; float s = 0.f;
        const bf16_t* kp = K + (size_t)(b * SEQ + blk * 256 + part * 64) * D + h * 128 + d;
        for (int r = 0; r < 64; ++r) s += bf2f(kp[(size_t)r * D]);
        red[part * 128 + d] = s; __syncthreads();
        if (tid < 128) KM[(size_t)u * 128 + tid] = (red[tid] + red[128 + tid] + red[256 + tid] + red[384 + tid]) * (1.f / 256.f);
        __syncthreads(); }
}

struct AttnArgs { const bf16_t* Q; int ldq; const bf16_t* K; const bf16_t* Kr; const bf16_t* VT; bf16_t* O; const float* KM; };
constexpr float NEGBIG = -1.0e30f;

template <int MODE>
__device__ __forceinline__ void attn_unit(LAS unsigned char* lds, const AttnArgs& A, int b, int h, int qb) {
    constexpr int DK = MODE == 0 ? 192 : 128, ND = DK / 16, CPK = DK / 8, KP = DK * 2 + 16, KTB = 64 * KP, VP = 136, VTB = 128 * VP, BUF = KTB + VTB, NKC = (64 * CPK) / 512, MISC = 2 * BUF;
    const int tid = threadIdx.x, lane = tid & 63, wave = __builtin_amdgcn_readfirstlane(tid >> 6), r32 = lane & 31, hi = lane >> 5;
    const int q0 = qb * 256, qw0 = q0 + wave * 32, qi = qw0 + r32;
    const size_t tokq = (size_t)b * SEQ + qi;
    bf16x8 qf[ND];
#pragma unroll
    for (int d0 = 0; d0 < 8; ++d0) qf[d0] = *(const bf16x8*)(A.Q + tokq * A.ldq + h * 128 + 16 * d0 + 8 * hi);
    LAS unsigned char* qlds = lds + MISC + wave * 8192 + lane * 16;
    if constexpr (MODE == 0) {
#pragma unroll
        for (int d0 = 0; d0 < 8; ++d0) *(LAS bf16x8*)(qlds + d0 * 1024) = qf[d0];
    }
    const bf16_t* qrp = A.Q + tokq * A.ldq + 2048 + h * 64 + 8 * hi;
    unsigned sel = 0u, umask = 0u; int nT = (q0 + 256) / 64;
    if constexpr (MODE == 2) {
        const int blk = qb;
        LAS unsigned* um = (LAS unsigned*)(lds + MISC); LAS float* km = (LAS float*)(lds + MISC + 64);
        for (int i = tid; i < blk * 128; i += 512) km[i] = A.KM[(size_t)((b * 16 + h) * 16) * 128 + i];
        if (tid == 0) um[0] = 0u;
        __syncthreads();
        float v0 = -INFINITY, v1 = -INFINITY, v2 = -INFINITY; int i0 = -1, i1 = -1, i2 = -1;
        for (int j = 0; j < blk; ++j) {
            float g = 0.f;
#pragma unroll
            for (int d0 = 0; d0 < 8; ++d0)
#pragma unroll
                for (int jj = 0; jj < 8; ++jj) g += bf2f((unsigned short)qf[d0][jj]) * km[j * 128 + 16 * d0 + 8 * hi + jj];
            g += xhalf(g);
            if (g > v0) { v2 = v1; i2 = i1; v1 = v0; i1 = i0; v0 = g; i0 = j; }
            else if (g > v1) { v2 = v1; i2 = i1; v1 = g; i1 = j; }
            else if (g > v2) { v2 = g; i2 = j; }
        }
        if (i0 >= 0) sel |= 1u << i0; if (i1 >= 0) sel |= 1u << i1; if (i2 >= 0) sel |= 1u << i2;
        if (sel) atomicOr((unsigned*)um, sel);
        __syncthreads();
        umask = um[0];
        nT = 4 + 4 * __builtin_popcount(umask);
    }
    auto tile_base = [&](int n) -> int {
        if constexpr (MODE == 0) return 64 * n;
        else if constexpr (MODE == 1) return 64 * (nT - 1 - n);
        else { if (n < 4) return q0 + 64 * n; unsigned m = umask; const int k = (n - 4) >> 2; for (int i = 0; i < k; ++i) m &= m - 1; return 256 * __builtin_ctz(m) + 64 * ((n - 4) & 3); }
    };
    u32x4 kreg[NKC]; u32x4 vreg[2];
#define ATT_LOAD(kbase_) do { const int kb_ = (kbase_); \
        _Pragma("unroll") for (int i_ = 0; i_ < NKC; ++i_) { const int c_ = tid + 512 * i_, key_ = c_ / CPK, part_ = c_ - key_ * CPK; const size_t tok_ = (size_t)b * SEQ + kb_ + key_; \
            const bf16_t* src_ = (MODE == 0 && part_ >= 16) ? A.Kr + tok_ * 64 + (part_ - 16) * 8 : A.K + tok_ * 2048 + h * 128 + part_ * 8; kreg[i_] = *(const u32x4*)src_; } \
        _Pragma("unroll") for (int i_ = 0; i_ < 2; ++i_) { const int c_ = tid + 512 * i_, d_ = c_ >> 3, part_ = c_ & 7; vreg[i_] = *(const u32x4*)(A.VT + (size_t)(h * 128 + d_) * T + (size_t)b * SEQ + kb_ + part_ * 8); } } while (0)
#define ATT_STORE(bufoff_) do { const int bo_ = (bufoff_); \
        _Pragma("unroll") for (int i_ = 0; i_ < NKC; ++i_) { const int c_ = tid + 512 * i_, key_ = c_ / CPK, part_ = c_ - key_ * CPK; *(LAS u32x4*)(lds + bo_ + key_ * KP + part_ * 16) = kreg[i_]; } \
        _Pragma("unroll") for (int i_ = 0; i_ < 2; ++i_) { const int c_ = tid + 512 * i_, d_ = c_ >> 3, part_ = c_ & 7; LAS unsigned char* p_ = lds + bo_ + KTB + d_ * VP + part_ * 16; \
            *(LAS u32x2*)p_ = (u32x2){vreg[i_].x, vreg[i_].y}; *(LAS u32x2*)(p_ + 8) = (u32x2){vreg[i_].z, vreg[i_].w}; } } while (0)

    f32x16 o[4];
#pragma unroll
    for (int i = 0; i < 4; ++i)
#pragma unroll
        for (int r = 0; r < 16; ++r) o[i][r] = 0.f;
    float mrun = NEGBIG, lrun = 0.f, carry = 0.f;

    ATT_LOAD(tile_base(0)); ATT_STORE(0); __syncthreads();
    for (int n = 0; n < nT; ++n) {
        const int kbase = tile_base(n), bufoff = (n & 1) * BUF;
        if (MODE != 0 && n + 1 < nT) ATT_LOAD(tile_base(n + 1));
        bool active, causal = false, off = false;
        if constexpr (MODE == 0) { active = kbase <= qw0 + 31; causal = kbase + 63 > qw0; }
        else if constexpr (MODE == 1) { active = kbase <= qw0 + 31; }
        else { if (n < 4) { active = kbase <= qw0 + 31; causal = kbase + 63 > qw0; }
               else { const int jb = kbase >> 8; off = ((sel >> jb) & 1u) == 0u; active = __ballot(!off) != 0ull; } }
        if (active) {
            f32x16 s0, s1;
#pragma unroll
            for (int r = 0; r < 16; ++r) { s0[r] = 0.f; s1[r] = 0.f; }
            const LAS unsigned char* kb = lds + bufoff + r32 * KP + hi * 16;
            bf16x8 qr[4];
            if constexpr (MODE == 0) { const bf16_t* qq = qrp; asm volatile("" : "+v"(qq));
#pragma unroll
                for (int e = 0; e < 4; ++e) qr[e] = *(const bf16x8*)(qq + 16 * e); }
#pragma unroll
            for (int d0 = 0; d0 < ND; ++d0) { const bf16x8 k0 = *(const LAS bf16x8*)(kb + d0 * 32), k1 = *(const LAS bf16x8*)(kb + 32 * KP + d0 * 32);
                bf16x8 qv;
                if constexpr (MODE == 0) { if (d0 < 8) qv = *(const LAS bf16x8*)(qlds + d0 * 1024); else qv = qr[d0 & 3]; } else qv = qf[d0];
                s0 = MFMA32(k0, qv, s0); s1 = MFMA32(k1, qv, s1); }
            bf16x8 pb[4];
            if constexpr (MODE == 1) {
                float X[32], LZ[32];
#pragma unroll
                for (int i = 0; i < 32; ++i) { const float z = i < 16 ? s0[i & 15] : s1[i & 15]; const int key = kbase + 8 * (i >> 2) + 4 * hi + (i & 3); const bool strict = key < qi;
                    const float u = __builtin_amdgcn_exp2f(-fabsf(z)); const float sp = fmaxf(z, 0.f) + __builtin_amdgcn_logf(1.f + u);
                    X[i] = strict ? -sp : 0.f; LZ[i] = strict ? (z - sp) : NEGBIG; }
                float gs[8], og[8];
#pragma unroll
                for (int g = 0; g < 8; ++g) { gs[g] = (X[4 * g] + X[4 * g + 1]) + (X[4 * g + 2] + X[4 * g + 3]); og[g] = xhalf(gs[g]); }
                float run = carry;
#pragma unroll
                for (int g = 7; g >= 0; --g) { const float a3 = run + (hi ? 0.f : og[g]); const float a2 = a3 + X[4 * g + 3], a1 = a2 + X[4 * g + 2], a0 = a1 + X[4 * g + 1];
                    LZ[4 * g + 3] = __builtin_amdgcn_exp2f(LZ[4 * g + 3] + a3); LZ[4 * g + 2] = __builtin_amdgcn_exp2f(LZ[4 * g + 2] + a2);
                    LZ[4 * g + 1] = __builtin_amdgcn_exp2f(LZ[4 * g + 1] + a1); LZ[4 * g] = __builtin_amdgcn_exp2f(LZ[4 * g] + a0);
                    run += gs[g] + og[g]; }
                carry = run;
#pragma unroll
                for (int c = 0; c < 4; ++c) { u32x4 w; w.x = cvtpk(LZ[8 * c], LZ[8 * c + 1]); w.y = cvtpk(LZ[8 * c + 2], LZ[8 * c + 3]); w.z = cvtpk(LZ[8 * c + 4], LZ[8 * c + 5]); w.w = cvtpk(LZ[8 * c + 6], LZ[8 * c + 7]); pb[c] = __builtin_bit_cast(bf16x8, w); }
            } else {
                if (causal) {
#pragma unroll
                    for (int r = 0; r < 16; ++r) { const int key = kbase + crow(r, hi); if (key > qi) s0[r] = NEGBIG; if (key + 32 > qi) s1[r] = NEGBIG; }
                }
                if (MODE == 2 && off) {
#pragma unroll
                    for (int r = 0; r < 16; ++r) { s0[r] = NEGBIG; s1[r] = NEGBIG; }
                }
                float mx = fmaxf(s0[0], s1[0]);
#pragma unroll
                for (int r = 1; r < 16; ++r) mx = fmaxf(mx, fmaxf(s0[r], s1[r]));
                mx = fmaxf(mx, xhalf(mx));
                const float mnew = fmaxf(mrun, mx), alpha = __builtin_amdgcn_exp2f(mrun - mnew); mrun = mnew;
                float ls = 0.f;
#pragma unroll
                for (int r = 0; r < 16; ++r) { s0[r] = __builtin_amdgcn_exp2f(s0[r] - mnew); s1[r] = __builtin_amdgcn_exp2f(s1[r] - mnew); ls += s0[r] + s1[r]; }
                lrun = lrun * alpha + ls;
#pragma unroll
                for (int i = 0; i < 4; ++i)
#pragma unroll
                    for (int r = 0; r < 16; ++r) o[i][r] *= alpha;
#pragma unroll
                for (int c = 0; c < 4; ++c) { u32x4 w;
                    if (c < 2) { w.x = cvtpk(s0[8 * c], s0[8 * c + 1]); w.y = cvtpk(s0[8 * c + 2], s0[8 * c + 3]); w.z = cvtpk(s0[8 * c + 4], s0[8 * c + 5]); w.w = cvtpk(s0[8 * c + 6], s0[8 * c + 7]); }
                    else { const int cc = c - 2; w.x = cvtpk(s1[8 * cc], s1[8 * cc + 1]); w.y = cvtpk(s1[8 * cc + 2], s1[8 * cc + 3]); w.z = cvtpk(s1[8 * cc + 4], s1[8 * cc + 5]); w.w = cvtpk(s1[8 * cc + 6], s1[8 * cc + 7]); }
                    pb[c] = __builtin_bit_cast(bf16x8, w); }
            }
            const LAS unsigned char* vb = lds + bufoff + KTB + r32 * VP + hi * 8;
#pragma unroll
            for (int db = 0; db < 4; ++db)
#pragma unroll
                for (int c = 0; c < 4; ++c) { const s16x4 lo = *(const LAS s16x4*)(vb + db * 32 * VP + c * 32), h4 = *(const LAS s16x4*)(vb + db * 32 * VP + c * 32 + 16);
                    const bf16x8 vf = {lo[0], lo[1], lo[2], lo[3], h4[0], h4[1], h4[2], h4[3]};
                    o[db] = MFMA32(vf, pb[c], o[db]); }
        }
        if (MODE == 0 && n + 1 < nT) ATT_LOAD(tile_base(n + 1));
        if (n + 1 < nT) ATT_STORE(((n + 1) & 1) * BUF);
        __syncthreads();
    }
#undef ATT_LOAD
#undef ATT_STORE
    float inv = 1.f;
    if constexpr (MODE != 1) { const float lt = lrun + xhalf(lrun); inv = 1.f / lt; }
    bf16_t* orow = A.O + tokq * D + h * 128 + 4 * hi;
#pragma unroll
    for (int db = 0; db < 4; ++db)
#pragma unroll
        for (int g = 0; g < 4; ++g) { u32x2 w; w.x = cvtpk(o[db][4 * g] * inv, o[db][4 * g + 1] * inv); w.y = cvtpk(o[db][4 * g + 2] * inv, o[db][4 * g + 3] * inv);
            *(u32x2*)(orow + 32 * db + 8 * g) = w; }
}

template <int MODE>
__device__ __forceinline__ void phase_attn(LAS unsigned char* lds, const AttnArgs& A, int vcu, int G) {
    if constexpr (MODE == 2) { for (int u = vcu; u < 512; u += G) { const int blk = 15 - (u >> 5), bh = u & 31; attn_unit<2>(lds, A, bh >> 4, bh & 15, blk); } }
    else { for (int it = vcu; it < 256; it += G) { const int bh = it >> 3, s = it & 7; attn_unit<MODE>(lds, A, bh >> 4, bh & 15, 15 - s); attn_unit<MODE>(lds, A, bh >> 4, bh & 15, s); } }
}

__device__ __forceinline__ void hgrn_h1_unit(LAS unsigned char* lds, const bf16_t* BIG, const float* lb, bf16_t* QT, float* OI, bf16_t* DELTA, float* DEC, int unit) {
    constexpr int QA = 0, KA0 = 17408, KA1 = 26112, KHT = 43520, VTL = 60928, SEGO = 78336, RP = 272, VP = 136;
    const int tid = threadIdx.x, lane = tid & 63, wave = __builtin_amdgcn_readfirstlane(tid >> 6), r32 = lane & 31, hi = lane >> 5;
    const int bh = unit >> 6, c = unit & 63, b = bh >> 4, h = bh & 15;
    const int d = tid & 127, part = tid >> 7;
    const size_t tok0 = (size_t)b * SEQ + c * 64 + part * 16;
    LAS float* SEG = (LAS float*)(lds + SEGO);
    const float lbd = lb[h * 128 + d], oml = 1.f - lbd;
    float qv[16], bb[16], kv[16]; float run = 0.f; unsigned vp[8];
#pragma unroll
    for (int i = 0; i < 16; ++i) { const bf16_t* row = BIG + (tok0 + i) * 8192 + h * 128 + d;
        const float q = bf2f(row[0]), fp = bf2f(row[2048]); const unsigned short vraw = row[4096];
        const float e = __expf(-fp); const float sig = 1.f / (1.f + e); const float f = lbd + oml * sig;
        const float lf = __logf(f); const float k = oml * (1.f - sig);
        run += lf; bb[i] = run; qv[i] = q; kv[i] = k;
        if (i & 1) vp[i >> 1] |= ((unsigned)vraw) << 16; else vp[i >> 1] = vraw; }
    SEG[part * 128 + d] = run;
    { LAS unsigned char* vt = lds + VTL + d * VP + part * 32;
#pragma unroll
      for (int j = 0; j < 4; ++j) *(LAS u32x2*)(vt + 8 * j) = (u32x2){vp[2 * j], vp[2 * j + 1]}; }
    __syncthreads();
    const float s0 = SEG[d], s1 = SEG[128 + d], s2 = SEG[256 + d], s3 = SEG[384 + d];
    const float prefix = part == 0 ? 0.f : part == 1 ? s0 : part == 2 ? s0 + s1 : (s0 + s1) + s2;
    const float bend = ((s0 + s1) + s2) + s3, beta1 = s0 + s1, betaI = part >= 2 ? beta1 : 0.f;
    unsigned khp[8];
#pragma unroll
    for (int i = 0; i < 16; ++i) { const float bt = prefix + bb[i]; const int t = part * 16 + i;
        *(LAS bf16_t*)(lds + QA + t * RP + 2 * d) = f2bf(qv[i] * __expf(bt - betaI));
        QT[(tok0 + i) * D + h * 128 + d] = f2bf(qv[i] * __expf(bt));
        if (part < 2) *(LAS bf16_t*)(lds + KA0 + t * RP + 2 * d) = f2bf(kv[i] * __expf(fminf(-bt, 80.f)));
        *(LAS bf16_t*)(lds + KA1 + t * RP + 2 * d) = f2bf(kv[i] * __expf(fminf(beta1 - bt, 80.f)));
        const unsigned short kh = f2bf(kv[i] * __expf(bend - bt));
        if (i & 1) khp[i >> 1] |= ((unsigned)kh) << 16; else khp[i >> 1] = kh; }
    { LAS unsigned char* kt = lds + KHT + d * VP + part * 32;
#pragma unroll
      for (int j = 0; j < 4; ++j) *(LAS u32x2*)(kt + 8 * j) = (u32x2){khp[2 * j], khp[2 * j + 1]}; }
    if (part == 0) DEC[(size_t)unit * 128 + d] = __expf(bend);
    __syncthreads();
    const int tg = wave & 1, dblk = wave >> 1;
    f32x16 sA0, sA1;
#pragma unroll
    for (int r = 0; r < 16; ++r) { sA0[r] = 0.f; sA1[r] = 0.f; }
    { const LAS unsigned char* qa = lds + QA + (32 * tg + r32) * RP + 16 * hi; const LAS unsigned char* ka = lds + (tg ? KA1 : KA0) + r32 * RP + 16 * hi;
#pragma unroll
      for (int d0 = 0; d0 < 8; ++d0) { const bf16x8 qfr = *(const LAS bf16x8*)(qa + 32 * d0); const bf16x8 k0 = *(const LAS bf16x8*)(ka + 32 * d0);
          sA0 = MFMA32(k0, qfr, sA0);
          if (tg) { const bf16x8 k1 = *(const LAS bf16x8*)(ka + 32 * RP + 32 * d0); sA1 = MFMA32(k1, qfr, sA1); } } }
    if (tg == 0) {
#pragma unroll
        for (int r = 0; r < 16; ++r) if (crow(r, hi) > r32) sA0[r] = 0.f;
    } else {
#pragma unroll
        for (int r = 0; r < 16; ++r) if (crow(r, hi) > r32) sA1[r] = 0.f;
    }
    bf16x8 pb[4];
#pragma unroll
    for (int cc = 0; cc < 2; ++cc) { u32x4 w; w.x = cvtpk(sA0[8 * cc], sA0[8 * cc + 1]); w.y = cvtpk(sA0[8 * cc + 2], sA0[8 * cc + 3]); w.z = cvtpk(sA0[8 * cc + 4], sA0[8 * cc + 5]); w.w = cvtpk(sA0[8 * cc + 6], sA0[8 * cc + 7]); pb[cc] = __builtin_bit_cast(bf16x8, w);
        u32x4 w2; w2.x = cvtpk(sA1[8 * cc], sA1[8 * cc + 1]); w2.y = cvtpk(sA1[8 * cc + 2], sA1[8 * cc + 3]); w2.z = cvtpk(sA1[8 * cc + 4], sA1[8 * cc + 5]); w2.w = cvtpk(sA1[8 * cc + 6], sA1[8 * cc + 7]); pb[2 + cc] = __builtin_bit_cast(bf16x8, w2); }
    bf16x8 vf[4];
    { const LAS unsigned char* vb = lds + VTL + (32 * dblk + r32) * VP + 8 * hi;
#pragma unroll
      for (int cc = 0; cc < 4; ++cc) { const s16x4 lo = *(const LAS s16x4*)(vb + 32 * cc), h4 = *(const LAS s16x4*)(vb + 32 * cc + 16); vf[cc] = (bf16x8){lo[0], lo[1], lo[2], lo[3], h4[0], h4[1], h4[2], h4[3]}; } }
    f32x16 oi;
#pragma unroll
    for (int r = 0; r < 16; ++r) oi[r] = 0.f;
    oi = MFMA32(vf[0], pb[0], oi); oi = MFMA32(vf[1], pb[1], oi);
    if (tg) { oi = MFMA32(vf[2], pb[2], oi); oi = MFMA32(vf[3], pb[3], oi); }
    { f32x4* op = (f32x4*)(OI + ((size_t)(unit * 8 + wave) * 64 + lane) * 16);
#pragma unroll
      for (int j = 0; j < 4; ++j) op[j] = (f32x4){oi[4 * j], oi[4 * j + 1], oi[4 * j + 2], oi[4 * j + 3]}; }
#pragma unroll
    for (int dbi = 0; dbi < 2; ++dbi) { const int db = 2 * tg + dbi; f32x16 dl;
#pragma unroll
        for (int r = 0; r < 16; ++r) dl[r] = 0.f;
        const LAS unsigned char* kb = lds + KHT + (32 * db + r32) * VP + 8 * hi;
#pragma unroll
        for (int cc = 0; cc < 4; ++cc) { const s16x4 lo = *(const LAS s16x4*)(kb + 32 * cc), h4 = *(const LAS s16x4*)(kb + 32 * cc + 16); const bf16x8 kf = {lo[0], lo[1], lo[2], lo[3], h4[0], h4[1], h4[2], h4[3]};
            dl = MFMA32(vf[cc], kf, dl); }
        bf16_t* dp = DELTA + ((size_t)unit * 128 + 32 * dblk) * 128 + 32 * db + r32;
#pragma unroll
        for (int r = 0; r < 16; ++r) dp[(size_t)crow(r, hi) * 128] = f2bf(dl[r]); }
    __syncthreads();
}
__device__ __forceinline__ void phase_hgrn_scan(bf16_t* DELTA, const float* DEC, int vcu, int G) {
    const int gt = vcu * 512 + threadIdx.x, NT = G * 512;
    for (int e = gt; e < 32 * 128 * 32; e += NT) { const int bh = e >> 12, v = (e >> 5) & 127, d4 = e & 31;
        float S0 = 0.f, S1 = 0.f, S2 = 0.f, S3 = 0.f;
#pragma unroll 8
        for (int c = 0; c < 64; ++c) { const size_t unit = (size_t)bh * 64 + c; u32x2* ptr = (u32x2*)(DELTA + (unit * 128 + v) * 128 + 4 * d4);
            const u32x2 raw = *ptr; const f32x4 dc = *(const f32x4*)(DEC + unit * 128 + 4 * d4);
            u32x2 w; w.x = cvtpk(S0, S1); w.y = cvtpk(S2, S3); *ptr = w;
            S0 = dc[0] * S0 + bflo(raw.x); S1 = dc[1] * S1 + bfhi(raw.x); S2 = dc[2] * S2 + bflo(raw.y); S3 = dc[3] * S3 + bfhi(raw.y); } }
}
__device__ __forceinline__ void hgrn_h3_unit(LAS unsigned char* lds, const bf16_t* BIG, const bf16_t* QT, const float* OI, const bf16_t* ST, const float* onorm, bf16_t* GO, int unit) {
    const int tid = threadIdx.x, lane = tid & 63, wave = __builtin_amdgcn_readfirstlane(tid >> 6), r32 = lane & 31, hi = lane >> 5;
    const int bh = unit >> 6, c = unit & 63, b = bh >> 4, h = bh & 15, tg = wave & 1, dblk = wave >> 1;
    const size_t tok = (size_t)b * SEQ + c * 64 + 32 * tg + r32;
    LAS float* red = (LAS float*)lds;
    f32x16 o;
    { const f32x4* op = (const f32x4*)(OI + ((size_t)(unit * 8 + wave) * 64 + lane) * 16);
#pragma unroll
      for (int j = 0; j < 4; ++j) { const f32x4 t4 = op[j]; o[4 * j] = t4[0]; o[4 * j + 1] = t4[1]; o[4 * j + 2] = t4[2]; o[4 * j + 3] = t4[3]; } }
    const bf16_t* sp = ST + ((size_t)unit * 128 + 32 * dblk + r32) * 128 + 8 * hi; const bf16_t* qp = QT + tok * D + h * 128 + 8 * hi;
#pragma unroll
    for (int d0 = 0; d0 < 8; ++d0) { const bf16x8 sf = *(const bf16x8*)(sp + 16 * d0), qfr = *(const bf16x8*)(qp + 16 * d0); o = MFMA32(sf, qfr, o); }
    float ss = 0.f;
#pragma unroll
    for (int r = 0; r < 16; ++r) ss += o[r] * o[r];
    ss += xhalf(ss);
    if (hi == 0) red[dblk * 64 + 32 * tg + r32] = ss;
    __syncthreads();
    const int t = 32 * tg + r32; const float tot = (red[t] + red[64 + t]) + (red[128 + t] + red[192 + t]);
    const float rinv = 1.f / sqrtf(tot * (1.f / 128.f) + RMS_EPS);
#pragma unroll
    for (int g = 0; g < 4; ++g) { const int v0 = 32 * dblk + 8 * g + 4 * hi; const f32x4 gn = *(const f32x4*)(onorm + h * 128 + v0);
        const u32x2 graw = *(const u32x2*)(BIG + tok * 8192 + 6144 + h * 128 + v0); const float g0 = bflo(graw.x), g1 = bfhi(graw.x), g2 = bflo(graw.y), g3 = bfhi(graw.y);
        const float y0 = o[4 * g] * rinv * gn[0] * (g0 / (1.f + __expf(-g0))), y1 = o[4 * g + 1] * rinv * gn[1] * (g1 / (1.f + __expf(-g1)));
        const float y2 = o[4 * g + 2] * rinv * gn[2] * (g2 / (1.f + __expf(-g2))), y3 = o[4 * g + 3] * rinv * gn[3] * (g3 / (1.f + __expf(-g3)));
        u32x2 w; w.x = cvtpk(y0, y1); w.y = cvtpk(y2, y3); *(u32x2*)(GO + tok * D + h * 128 + v0) = w; }
    __syncthreads();
}

template <class Epi>
__device__ __forceinline__ void run_gemm(LAS unsigned char* lds, const bf16_t* A, const bf16_t* Bt, int M, int N, int K, const Epi& E, int G) {
    pg8::Gemm g{A, Bt, M, N, K}; pg8::StaticOrder S; S.init(M, N, G, (int)blockIdx.x);
    pg8::gemm_phase<Epi, pg8::StaticOrder, true, true>((PG8_LAS unsigned char*)lds, g, S, E);
}
__device__ __forceinline__ pg8::EpiStore epi_plain(bf16_t* O, int ldc, float scale = 1.f, int act = 0) {
    pg8::EpiStore e; e.O = O; e.ldc = ldc; e.scale = scale; e.act = act; e.O2 = nullptr; e.split_col = 1 << 30; e.ldc2 = 0; e.scale2 = 1.f; e.rope = nullptr; e.rope_col = 1 << 30; return e;
}

__global__ void __launch_bounds__(512) fwd_megakernel(Params p) {
    extern __shared__ __attribute__((aligned(16))) unsigned char lds_raw[];
    LAS unsigned char* lds = (LAS unsigned char*)lds_raw;
    cg::grid_group grid = cg::this_grid();
    const int G = gridDim.x, bx = blockIdx.x; const int vcu = (G % 8 == 0) ? (bx % 8) * (G / 8) + bx / 8 : bx;
    unsigned char* ws = p.ws;
    const int lo = p.ph_lo, hi = p.ph_hi; int ph = 0;
#define PH_BEGIN if (ph >= lo && ph < hi) {
#define PH_END   if (ph + 1 < hi) grid.sync(); } ++ph;
    float* H32 = (float*)(ws + WS_H32); bf16_t* HB = (bf16_t*)(ws + WS_HB); bf16_t* BIG = (bf16_t*)(ws + WS_BIG);
    const float* ln_g = p.in[15]; const float* ln_b = p.in[16];
    bf16_t* VT = (bf16_t*)(ws + WS_VT); bf16_t* OB = (bf16_t*)(ws + WS_O);

    PH_BEGIN phase_prologue(p, lds, vcu, G); PH_END

    PH_BEGIN run_gemm(lds, HB, (const bf16_t*)(ws + WS_W_MLAIN), T, 1280, D, epi_plain((bf16_t*)(ws + WS_H0), 1280), G); PH_END
    PH_BEGIN phase_mla_prep((const bf16_t*)(ws + WS_H0), p.in[2], p.in[3], (const float*)(ws + WS_ROPE), (bf16_t*)(ws + WS_CQN), (bf16_t*)(ws + WS_CKVN), (bf16_t*)(ws + WS_KR), vcu, G); PH_END
    PH_BEGIN {
        pg8::EpiStore eq = epi_plain((bf16_t*)(ws + WS_Q3), 3072, 0.07216878364870322f * LOG2E); eq.rope = (const float*)(ws + WS_ROPE); eq.rope_col = 2048;
        run_gemm(lds, (const bf16_t*)(ws + WS_CQN), (const bf16_t*)(ws + WS_W_UQ), T, 3072, 512, eq, G);
        run_gemm(lds, (const bf16_t*)(ws + WS_CKVN), (const bf16_t*)(ws + WS_W_UK), T, 2048, 512, epi_plain((bf16_t*)(ws + WS_KN), 2048), G);
        run_gemm(lds, (const bf16_t*)(ws + WS_W_UV), (const bf16_t*)(ws + WS_CKVN), 2048, T, 512, epi_plain(VT, T), G);
    } PH_END
    PH_BEGIN { AttnArgs a{(const bf16_t*)(ws + WS_Q3), 3072, (const bf16_t*)(ws + WS_KN), (const bf16_t*)(ws + WS_KR), VT, OB, nullptr}; phase_attn<0>(lds, a, vcu, G); } PH_END
    PH_BEGIN { pg8::EpiRes e{p.in[0], H32, D, ALPHA}; run_gemm(lds, OB, (const bf16_t*)(ws + WS_W_MLAO), T, D, D, e, G); } PH_END

#define MLP_BLOCK(L, OUT32, OUTB) \
    PH_BEGIN phase_ln(H32, ln_g + ((L) * 2 + 0) * D, ln_b + ((L) * 2 + 0) * D, H32, HB, vcu, G); PH_END \
    PH_BEGIN run_gemm(lds, HB, (const bf16_t*)(ws + WS_W1) + (size_t)(L) * D * FF, T, FF, D, epi_plain(BIG, FF, 1.f, 1), G); PH_END \
    PH_BEGIN { pg8::EpiRes e{H32, H32, D, ALPHA}; run_gemm(lds, BIG, (const bf16_t*)(ws + WS_W2) + (size_t)(L) * D * FF, T, D, FF, e, G); } PH_END \
    PH_BEGIN phase_ln(H32, ln_g + ((L) * 2 + 1) * D, ln_b + ((L) * 2 + 1) * D, (OUT32), (OUTB), vcu, G); PH_END

    MLP_BLOCK(0, H32, HB)

    PH_BEGIN run_gemm(lds, HB, (const bf16_t*)(ws + WS_W_HGIN), T, 8192, D, epi_plain(BIG, 8192), G); PH_END
    PH_BEGIN for (int u = vcu; u < 2048; u += G) hgrn_h1_unit(lds, BIG, (const float*)(ws + WS_LB), (bf16_t*)(ws + WS_QT), (float*)(ws + WS_OI), (bf16_t*)(ws + WS_DELTA), (float*)(ws + WS_DEC), u); PH_END
    PH_BEGIN phase_hgrn_scan((bf16_t*)(ws + WS_DELTA), (const float*)(ws + WS_DEC), vcu, G); PH_END
    PH_BEGIN for (int u = vcu; u < 2048; u += G) hgrn_h3_unit(lds, BIG, (const bf16_t*)(ws + WS_QT), (const float*)(ws + WS_OI), (const bf16_t*)(ws + WS_DELTA), p.in[9], (bf16_t*)(ws + WS_GO), u); PH_END
    PH_BEGIN { pg8::EpiRes e{H32, H32, D, ALPHA}; run_gemm(lds, (const bf16_t*)(ws + WS_GO), (const bf16_t*)(ws + WS_W_HGO), T, D, D, e, G); } PH_END
    MLP_BLOCK(1, H32, HB)

    PH_BEGIN {
        pg8::EpiStore eq = epi_plain((bf16_t*)(ws + WS_Q), 2048, 0.08838834764831845f * LOG2E); eq.O2 = (bf16_t*)(ws + WS_K); eq.split_col = 2048; eq.ldc2 = 2048; eq.scale2 = 1.f;
        run_gemm(lds, HB, (const bf16_t*)(ws + WS_W_SBIN), T, 4096, D, eq, G);
        run_gemm(lds, (const bf16_t*)(ws + WS_W_SBIN) + (size_t)4096 * D, HB, 2048, T, D, epi_plain(VT, T), G);
    } PH_END
    PH_BEGIN { AttnArgs a{(const bf16_t*)(ws + WS_Q), 2048, (const bf16_t*)(ws + WS_K), nullptr, VT, OB, nullptr}; phase_attn<1>(lds, a, vcu, G); } PH_END
    PH_BEGIN { pg8::EpiRes e{H32, H32, D, ALPHA}; run_gemm(lds, OB, (const bf16_t*)(ws + WS_W_SBO), T, D, D, e, G); } PH_END
    MLP_BLOCK(2, H32, HB)

    PH_BEGIN {
        pg8::EpiStore eq = epi_plain((bf16_t*)(ws + WS_Q), 2048, 0.08838834764831845f * LOG2E); eq.O2 = (bf16_t*)(ws + WS_K); eq.split_col = 2048; eq.ldc2 = 2048; eq.scale2 = 1.f;
        run_gemm(lds, HB, (const bf16_t*)(ws + WS_W_MBIN), T, 4096, D, eq, G);
        run_gemm(lds, (const bf16_t*)(ws + WS_W_MBIN) + (size_t)4096 * D, HB, 2048, T, D, epi_plain(VT, T), G);
    } PH_END
    PH_BEGIN phase_kmean((const bf16_t*)(ws + WS_K), (float*)(ws + WS_KMEAN), lds, vcu, G); PH_END
    PH_BEGIN { AttnArgs a{(const bf16_t*)(ws + WS_Q), 2048, (const bf16_t*)(ws + WS_K), nullptr, VT, OB, (const float*)(ws + WS_KMEAN)}; phase_attn<2>(lds, a, vcu, G); } PH_END
    PH_BEGIN { pg8::EpiRes e{H32, H32, D, ALPHA}; run_gemm(lds, OB, (const bf16_t*)(ws + WS_W_MBO), T, D, D, e, G); } PH_END
    MLP_BLOCK(3, p.out, (bf16_t*)nullptr)
#undef PH_BEGIN
#undef PH_END
}

extern "C" void kernel_launch(void* const* d_in, const int* in_sizes, int n_in, void* d_out, int out_size, void* d_ws, size_t ws_size, hipStream_t stream) {
    static int grid = 0;
    if (grid == 0) {
        if (n_in != 19 || out_size != T * D || ws_size < WS_END) { fprintf(stderr, "kernel_launch: unexpected problem shape (n_in %d out %d ws %zu)\n", n_in, out_size, ws_size); grid = -1; return; }
        int dev = 0, cus = 0, per_cu = 0;
        (void)hipGetDevice(&dev); (void)hipDeviceGetAttribute(&cus, hipDeviceAttributeMultiprocessorCount, dev);
        if (hipFuncSetAttribute((const void*)fwd_megakernel, hipFuncAttributeMaxDynamicSharedMemorySize, LDS_BYTES) != hipSuccess) { fprintf(stderr, "kernel_launch: hipFuncSetAttribute failed\n"); grid = -1; return; }
        if (hipOccupancyMaxActiveBlocksPerMultiprocessor(&per_cu, (const void*)fwd_megakernel, 512, LDS_BYTES) != hipSuccess || per_cu < 1) { fprintf(stderr, "kernel_launch: occupancy query says %d\n", per_cu); per_cu = 1; }
        (void)hipGetLastError();
        grid = cus;
    }
    if (grid < 0) return;
    Params p{};
    for (int i = 0; i < 19; ++i) p.in[i] = (const float*)d_in[i];
    p.out = (float*)d_out; p.ws = (unsigned char*)d_ws; p.ph_lo = 0; p.ph_hi = 1 << 20;
    void* args[] = {&p};
    hipError_t e = hipLaunchCooperativeKernel((const void*)fwd_megakernel, dim3(grid), dim3(512), args, LDS_BYTES, stream);
    if (e != hipSuccess) fprintf(stderr, "kernel_launch: cooperative launch failed: %s (grid %d)\n", hipGetErrorString(e), grid);
}
```

```cpp
#include <hip/hip_runtime.h>
#include <hip/hip_cooperative_groups.h>
#include <cstdio>
#include <cstdint>
namespace cg = cooperative_groups;

namespace pg8 {
#define PG8_LAS __attribute__((address_space(3)))
typedef unsigned short bf16_t;
typedef short bf16x8 __attribute__((ext_vector_type(8)));
typedef float f32x4 __attribute__((ext_vector_type(4)));
typedef unsigned u32x4 __attribute__((ext_vector_type(4)));
constexpr int BM = 256, BK = 64, HALF = 128, HTB = HALF * BK * 2  , STAGE_BYTES = 8 * HTB, NXCD = 8, WGM = 8;

__host__ __device__ __forceinline__ int lds_byte(int r, int c) { const int st = (r >> 4) * 2 + (c >> 5), rr = r & 15, cc = c & 31, ob = rr * 64 + cc * 2; return st * 1024 + (ob ^ (((ob >> 9) & 1) << 5)); }
__host__ __device__ __forceinline__ void stage_rc(int b, int& R, int& C) { const int st = b / 1024, sb = b % 1024, swz = sb ^ (((sb >> 9) & 1) << 5); R = (st >> 1) * 16 + swz / 64; C = (st & 1) * 32 + (swz % 64) / 2; }
__host__ __device__ __forceinline__ int perm32(int rho) { const int n = rho >> 4, i = rho & 15; return 8 * (i >> 2) + 4 * n + (i & 3); }

struct Unit { int pm, pn; };
struct Gemm { const bf16_t* A; const bf16_t* Bt; int M, N, K; };

struct StaticOrder {
    int nM, nN, nwg, G, c;
    __host__ __device__ void init(int M, int N, int G_, int c_) { nM = M / BM; nN = N / BM; nwg = nM * nN; G = G_; c = c_; }
    __host__ __device__ bool next(int i, Unit& u) const {
        const long L = (long)i * G + c; if (L >= nwg) return false;
        int wgid = (int)L; { const int q = nwg / NXCD, r = nwg % NXCD, xcd = wgid % NXCD, off = wgid / NXCD; wgid = (xcd < r ? xcd * (q + 1) : r * (q + 1) + (xcd - r) * q) + off; }
        const int nig = WGM * nN, gid = wgid / nig, fm = gid * WGM, gsz = (nM - fm) < WGM ? (nM - fm) : WGM;
        u.pm = fm + ((wgid % nig) % gsz); u.pn = (wgid % nig) / gsz; return true;
    }
    __device__ __forceinline__ void a_ready(const Unit&) const {}
    __device__ __forceinline__ void done(const Unit&) const {}
};

typedef float f32x2 __attribute__((ext_vector_type(2)));
typedef __bf16 bf16x2_t __attribute__((ext_vector_type(2)));
__device__ __forceinline__ unsigned cvtpk(float lo, float hi) { f32x2 v = {lo, hi}; bf16x2_t b = __builtin_convertvector(v, bf16x2_t); return __builtin_bit_cast(unsigned, b); }

struct EpiStore {
    static constexpr bool PERM = true, AFTER_DRAIN = false;
    bf16_t* O; int ldc; float scale; int act;
    bf16_t* O2; int split_col; int ldc2; float scale2;
    const float* rope; int rope_col;
    __device__ __forceinline__ void operator()(const f32x4 (&acc)[2][2][4][2], const Unit& u, int wr, int wc, int fr, int fq) const {
        const int row0 = u.pm * BM + wr * 64 + fr; int colt = u.pn * BM; bf16_t* base = O; int ld = ldc; float sc = scale;
        const bool do_rope = (rope != nullptr) && (colt >= rope_col);
        if (colt >= split_col) { base = O2; ld = ldc2; sc = scale2; colt -= split_col; }
        const int col0 = colt + wc * 32 + 8 * fq;
#pragma unroll
        for (int ai = 0; ai < 2; ++ai)
#pragma unroll
            for (int m = 0; m < 4; ++m) { const int row = row0 + ai * HALF + m * 16; bf16_t* rowp = base + (size_t)row * ld + col0;
#pragma unroll
                for (int bj = 0; bj < 2; ++bj) { f32x4 v0 = acc[ai][bj][m][0], v1 = acc[ai][bj][m][1];
                    if (act == 1) {
#pragma unroll
                        for (int e = 0; e < 4; ++e) { float a = fmaxf(v0[e], 0.f), b = fmaxf(v1[e], 0.f); v0[e] = a * a; v1[e] = b * b; } }
                    if (do_rope) { const int gc = u.pn * BM + bj * HALF + wc * 32 + 8 * fq - rope_col; const int i0 = (gc & 63) >> 1; const int pos = row & 4095;
                        const f32x4 t0 = *(const f32x4*)(rope + ((size_t)pos * 32 + i0) * 2), t1 = *(const f32x4*)(rope + ((size_t)pos * 32 + i0 + 2) * 2);
                        f32x4 w0, w1;
                        w0[0] = v0[0] * t0[0] - v0[1] * t0[1]; w0[1] = v0[1] * t0[0] + v0[0] * t0[1];
                        w0[2] = v0[2] * t0[2] - v0[3] * t0[3]; w0[3] = v0[3] * t0[2] + v0[2] * t0[3];
                        w1[0] = v1[0] * t1[0] - v1[1] * t1[1]; w1[1] = v1[1] * t1[0] + v1[0] * t1[1];
                        w1[2] = v1[2] * t1[2] - v1[3] * t1[3]; w1[3] = v1[3] * t1[2] + v1[2] * t1[3];
                        v0 = w0; v1 = w1; }
                    v0 = v0 * sc; v1 = v1 * sc; u32x4 w; w.x = cvtpk(v0[0], v0[1]); w.y = cvtpk(v0[2], v0[3]); w.z = cvtpk(v1[0], v1[1]); w.w = cvtpk(v1[2], v1[3]);
                    *(u32x4*)(rowp + bj * HALF) = w; } }
    }
};
struct EpiRes {
    static constexpr bool PERM = false, AFTER_DRAIN = false;
    const float* hin; float* z; int ldc; float alpha;
    __device__ __forceinline__ void operator()(const f32x4 (&acc)[2][2][4][2], const Unit& u, int wr, int wc, int fr, int fq) const {
        const int row0 = u.pm * BM + wr * 64 + fr, col0 = u.pn * BM + wc * 32 + 4 * fq;
#pragma unroll
        for (int ai = 0; ai < 2; ++ai)
#pragma unroll
            for (int m = 0; m < 4; ++m) { const size_t off = (size_t)(row0 + ai * HALF + m * 16) * ldc + col0;
#pragma unroll
                for (int bj = 0; bj < 2; ++bj)
#pragma unroll
                    for (int n = 0; n < 2; ++n) { const f32x4 h4 = *(const f32x4*)(hin + off + bj * HALF + n * 16); *(f32x4*)(z + off + bj * HALF + n * 16) = h4 * alpha + acc[ai][bj][m][n]; } }
    }
};
template <class Epi, class Sched, bool ALIGN_EPI = false, bool SP2 = false>
__device__ __forceinline__ void gemm_phase(PG8_LAS unsigned char* lds, const Gemm g, const Sched& S, const Epi& E) {
    const int tid = threadIdx.x, wid = __builtin_amdgcn_readfirstlane(tid >> 6), lane = tid & 63, wr = wid >> 2, wc = wid & 3, fr = lane & 15, fq = lane >> 4;
    const int K = g.K, nt = K / BK;
    unsigned voffA[2], voffB[2];
#pragma unroll
    for (int i = 0; i < 2; ++i) { int R, C; stage_rc(tid * 16 + i * 8192, R, C); const int Rb = Epi::PERM ? ((R & ~31) + perm32(R & 31)) : R;
        voffA[i] = (unsigned)(R * K + C) * 2u; voffB[i] = (unsigned)(Rb * K + C) * 2u; }
    const size_t kstep = (size_t)(BK * 2);
    const size_t hstep = (size_t)HALF * K * 2;
    const size_t tstep = 2 * hstep;
    const unsigned ldsw = (unsigned)wid * 1024u;
    const int aoff = lds_byte(wr * 64 + fr, fq * 8), boff = lds_byte(wc * 32 + fr, fq * 8);
#define PG8_SA(b, h) (((b) * 2 + (h)) * HTB)
#define PG8_SB(b, h) ((4 + (b) * 2 + (h)) * HTB)
#define PG8_STAGE(bufoff, gbase, voff) do { _Pragma("unroll") for (int _i = 0; _i < 2; ++_i) \
        __builtin_amdgcn_global_load_lds((const unsigned*)((const char*)(gbase) + (voff)[_i]), (PG8_LAS unsigned*)(lds + (bufoff) + ldsw + _i * 8192), 16, 0, 0); } while (0)
#define PG8_LDA(dst, b, h) do { _Pragma("unroll") for (int m = 0; m < 4; ++m) _Pragma("unroll") for (int k = 0; k < 2; ++k) dst[m][k] = *(const PG8_LAS bf16x8*)(lds + PG8_SA(b, h) + aoff + m * 2048 + k * 1024); } while (0)
#define PG8_LDB(dst, b, h) do { _Pragma("unroll") for (int n = 0; n < 2; ++n) _Pragma("unroll") for (int k = 0; k < 2; ++k) dst[n][k] = *(const PG8_LAS bf16x8*)(lds + PG8_SB(b, h) + boff + n * 2048 + k * 1024); } while (0)
#define PG8_MMA(ai, bj, At, Bt) do { __builtin_amdgcn_s_setprio(1); _Pragma("unroll") for (int m = 0; m < 4; ++m) _Pragma("unroll") for (int n = 0; n < 2; ++n) _Pragma("unroll") for (int k = 0; k < 2; ++k) \
        acc[ai][bj][m][n] = __builtin_amdgcn_mfma_f32_16x16x32_bf16(Bt[n][k], At[m][k], acc[ai][bj][m][n], 0, 0, 0); __builtin_amdgcn_s_setprio(0); } while (0)
#define PG8_WAIT_V(n) asm volatile("s_waitcnt vmcnt(" #n ")" ::: "memory")
#define PG8_WAIT_L(n) asm volatile("s_waitcnt lgkmcnt(" #n ")" ::: "memory")
#define PG8_BAR __builtin_amdgcn_s_barrier()
#define PG8_SCHED __builtin_amdgcn_sched_barrier(0)
    Unit cur, nxt; int ui = 0;
    if (!S.next(0, cur)) return;
    f32x4 acc[2][2][4][2];
#pragma unroll
    for (int a = 0; a < 2; ++a)
#pragma unroll
        for (int b = 0; b < 2; ++b)
#pragma unroll
            for (int m = 0; m < 4; ++m)
#pragma unroll
                for (int n = 0; n < 2; ++n) acc[a][b][m][n] = (f32x4){0.f, 0.f, 0.f, 0.f};
    bf16x8 At[4][2], B0[2][2], B1[2][2];
    const char* cA = (const char*)g.A + (size_t)cur.pm * tstep; const char* cB = (const char*)g.Bt + (size_t)cur.pn * tstep;
    S.a_ready(cur);
    if constexpr (SP2) {
        PG8_STAGE(PG8_SB(0, 0), cB, voffB); PG8_STAGE(PG8_SB(0, 1), cB + hstep, voffB); PG8_STAGE(PG8_SA(0, 0), cA, voffA); PG8_STAGE(PG8_SA(0, 1), cA + hstep, voffA);
        if (wr == 1) PG8_BAR;
        PG8_WAIT_V(2); PG8_BAR;
        PG8_STAGE(PG8_SB(1, 0), cB + kstep, voffB); PG8_STAGE(PG8_SA(1, 0), cA + kstep, voffA); PG8_STAGE(PG8_SB(1, 1), cB + hstep + kstep, voffB);
        PG8_WAIT_V(6); PG8_BAR;
    } else {
        PG8_STAGE(PG8_SB(0, 0), cB, voffB); PG8_STAGE(PG8_SA(0, 0), cA, voffA); PG8_STAGE(PG8_SB(0, 1), cB + hstep, voffB); PG8_STAGE(PG8_SA(0, 1), cA + hstep, voffA);
        if (wr == 1) PG8_BAR;
        PG8_WAIT_V(4); PG8_BAR;
        PG8_STAGE(PG8_SB(1, 0), cB + kstep, voffB); PG8_STAGE(PG8_SA(1, 0), cA + kstep, voffA); PG8_STAGE(PG8_SB(1, 1), cB + hstep + kstep, voffB);
        PG8_WAIT_V(6); PG8_BAR;
    }
    for (;;) {
        const bool has_next = S.next(ui + 1, nxt);
        const char* nA = has_next ? (const char*)g.A + (size_t)nxt.pm * tstep : cA; const char* nB = has_next ? (const char*)g.Bt + (size_t)nxt.pn * tstep : cB;
        for (int t = 0; t < nt; t += 2) {
            const bool last = (t == nt - 2);
            const char* a1 = cA + (size_t)(t + 1) * kstep;
            const char* a2 = last ? nA : cA + (size_t)(t + 2) * kstep; const char* b2 = last ? nB : cB + (size_t)(t + 2) * kstep;
            const char* a3 = a2 + kstep; const char* b3 = b2 + kstep;
            if (last && has_next) S.a_ready(nxt);
            if constexpr (SP2) {
            PG8_LDB(B0, 0, 0); PG8_LDB(B1, 0, 1); PG8_SCHED; PG8_LDA(At, 0, 0); PG8_STAGE(PG8_SA(1, 1), a1 + hstep, voffA);
            PG8_WAIT_V(8); PG8_WAIT_L(0); PG8_BAR; PG8_MMA(0, 0, At, B0); PG8_MMA(0, 1, At, B1); PG8_BAR; PG8_SCHED;
            PG8_LDA(At, 0, 1); PG8_STAGE(PG8_SB(0, 0), b2, voffB); PG8_STAGE(PG8_SB(0, 1), b2 + hstep, voffB); PG8_STAGE(PG8_SA(0, 0), a2, voffA);
            PG8_WAIT_V(8); PG8_WAIT_L(0); PG8_BAR; PG8_MMA(1, 0, At, B0); PG8_MMA(1, 1, At, B1); PG8_BAR; PG8_SCHED;
            PG8_LDB(B0, 1, 0); PG8_LDB(B1, 1, 1); PG8_SCHED; PG8_LDA(At, 1, 0); PG8_STAGE(PG8_SA(0, 1), a2 + hstep, voffA);
            PG8_WAIT_V(8); PG8_WAIT_L(0); PG8_BAR; PG8_MMA(0, 0, At, B0); PG8_MMA(0, 1, At, B1); PG8_BAR; PG8_SCHED;
            PG8_LDA(At, 1, 1); PG8_STAGE(PG8_SB(1, 0), b3, voffB); PG8_STAGE(PG8_SB(1, 1), b3 + hstep, voffB); PG8_STAGE(PG8_SA(1, 0), a3, voffA);
            PG8_WAIT_V(8); PG8_WAIT_L(0); PG8_BAR; PG8_MMA(1, 0, At, B0); PG8_MMA(1, 1, At, B1); PG8_BAR; PG8_SCHED;
            } else {
            PG8_LDB(B0, 0, 0); PG8_SCHED; PG8_LDA(At, 0, 0); PG8_STAGE(PG8_SA(1, 1), a1 + hstep, voffA);
            PG8_WAIT_L(8); PG8_BAR; PG8_WAIT_L(0); PG8_MMA(0, 0, At, B0); PG8_BAR; PG8_SCHED;
            PG8_LDB(B1, 0, 1); PG8_STAGE(PG8_SB(0, 0), b2, voffB);
            PG8_BAR; PG8_WAIT_L(0); PG8_MMA(0, 1, At, B1); PG8_BAR;
            PG8_LDA(At, 0, 1); PG8_STAGE(PG8_SA(0, 0), a2, voffA);
            PG8_BAR; PG8_WAIT_L(0); PG8_MMA(1, 0, At, B0); PG8_BAR; PG8_SCHED;
            PG8_STAGE(PG8_SB(0, 1), b2 + hstep, voffB);
            PG8_WAIT_V(6); PG8_BAR; PG8_MMA(1, 1, At, B1); PG8_BAR;
            PG8_LDB(B0, 1, 0); PG8_SCHED; PG8_LDA(At, 1, 0); PG8_STAGE(PG8_SA(0, 1), a2 + hstep, voffA);
            PG8_WAIT_L(8); PG8_BAR; PG8_WAIT_L(0); PG8_MMA(0, 0, At, B0); PG8_BAR; PG8_SCHED;
            PG8_LDB(B1, 1, 1); PG8_STAGE(PG8_SB(1, 0), b3, voffB);
            PG8_BAR; PG8_WAIT_L(0); PG8_MMA(0, 1, At, B1); PG8_BAR;
            PG8_LDA(At, 1, 1); PG8_STAGE(PG8_SA(1, 0), a3, voffA);
            PG8_BAR; PG8_WAIT_L(0); PG8_MMA(1, 0, At, B0); PG8_BAR; PG8_SCHED;
            PG8_STAGE(PG8_SB(1, 1), b3 + hstep, voffB);
            PG8_WAIT_V(6); PG8_BAR; PG8_MMA(1, 1, At, B1); PG8_BAR;
            }
        }
        if constexpr (ALIGN_EPI) { if (wr == 0) PG8_BAR; }
        if constexpr (!Epi::AFTER_DRAIN) { E(acc, cur, wr, wc, fr, fq); S.done(cur); }
        if (!has_next) break;
#pragma unroll
        for (int a = 0; a < 2; ++a)
#pragma unroll
            for (int b = 0; b < 2; ++b)
#pragma unroll
                for (int m = 0; m < 4; ++m)
#pragma unroll
                    for (int n = 0; n < 2; ++n) acc[a][b][m][n] = (f32x4){0.f, 0.f, 0.f, 0.f};
        cur = nxt; cA = nA; cB = nB; ++ui;
        if constexpr (ALIGN_EPI) { if (wr == 1) PG8_BAR; }
    }
    PG8_WAIT_V(0);
    if constexpr (!ALIGN_EPI) { if (wr == 0) PG8_BAR; }
    PG8_BAR;
    if constexpr (Epi::AFTER_DRAIN) { E.fused(acc, cur, wr, wc, fr, fq, lds, wid, lane); S.done(cur); }
#undef PG8_SA
#undef PG8_SB
#undef PG8_STAGE
#undef PG8_LDA
#undef PG8_LDB
#undef PG8_MMA
#undef PG8_WAIT_V
#undef PG8_WAIT_L
#undef PG8_BAR
#undef PG8_SCHED
}
}

#define LAS __attribute__((address_space(3)))
typedef unsigned short bf16_t;
typedef float f32x4 __attribute__((ext_vector_type(4)));
typedef float f32x16 __attribute__((ext_vector_type(16)));
typedef short bf16x8 __attribute__((ext_vector_type(8)));
typedef short s16x4 __attribute__((ext_vector_type(4)));
typedef unsigned u32x4 __attribute__((ext_vector_type(4)));
typedef unsigned u32x2 __attribute__((ext_vector_type(2)));
using pg8::cvtpk;
#define MFMA32(a, b, c) __builtin_amdgcn_mfma_f32_32x32x16_bf16((a), (b), (c), 0, 0, 0)

constexpr int T = 8192, SEQ = 4096, D = 2048, FF = 8192, NH = 16;
constexpr float ALPHA = 1.681792830507429f;
constexpr float LN_EPS = 1e-5f, RMS_EPS = 1e-6f;
constexpr float LOG2E = 1.4426950408889634f;

constexpr size_t MiB = 1u << 20;
constexpr size_t WS_ROPE = 1 * MiB, WS_LB = 2 * MiB, WS_KMEAN = 3 * MiB;
constexpr size_t WS_W_MLAIN = 4 * MiB, WS_W_UQ = 9 * MiB, WS_W_UK = 12 * MiB, WS_W_UV = 14 * MiB, WS_W_MLAO = 16 * MiB;
constexpr size_t WS_W_HGIN = 24 * MiB, WS_W_HGO = 56 * MiB, WS_W_SBIN = 64 * MiB, WS_W_SBO = 88 * MiB, WS_W_MBIN = 96 * MiB, WS_W_MBO = 120 * MiB;
constexpr size_t WS_W1 = 128 * MiB, WS_W2 = 256 * MiB;
constexpr size_t WS_H32 = 384 * MiB, WS_HB = 448 * MiB, WS_BIG = 480 * MiB, WS_MIX = 608 * MiB;
constexpr size_t WS_H0 = WS_MIX, WS_CQN = WS_MIX + 20 * MiB, WS_CKVN = WS_MIX + 28 * MiB, WS_KR = WS_MIX + 36 * MiB, WS_Q3 = WS_MIX + 40 * MiB, WS_KN = WS_MIX + 88 * MiB, WS_VT = WS_MIX + 120 * MiB, WS_O = WS_MIX + 152 * MiB;
constexpr size_t WS_Q = WS_MIX, WS_K = WS_MIX + 32 * MiB;
constexpr size_t WS_QT = WS_MIX, WS_OI = WS_MIX + 32 * MiB, WS_DELTA = WS_MIX + 96 * MiB, WS_DEC = WS_MIX + 160 * MiB, WS_GO = WS_MIX + 162 * MiB;
constexpr size_t WS_END = WS_MIX + 200 * MiB;
static_assert(WS_END <= 1024 * MiB, "workspace");

constexpr int LDS_BYTES = 155648;
constexpr int NWAVES = 8;

__device__ __forceinline__ float bflo(unsigned u) { return __uint_as_float(u << 16); }
__device__ __forceinline__ float bfhi(unsigned u) { return __uint_as_float(u & 0xffff0000u); }
__device__ __forceinline__ float bf2f(unsigned short b) { return __uint_as_float(((unsigned)b) << 16); }
__device__ __forceinline__ unsigned short f2bf(float f) { return (unsigned short)(cvtpk(f, 0.f) & 0xffffu); }
__device__ __forceinline__ float wave_sum(float v) {
#pragma unroll
    for (int o = 1; o < 64; o <<= 1) v += __shfl_xor(v, o);
    return v;
}
__device__ __forceinline__ float xhalf(float v) {
    auto rr = __builtin_amdgcn_permlane32_swap(__float_as_uint(v), __float_as_uint(v), false, false);
    return __uint_as_float((threadIdx.x & 32) ? rr[0] : rr[1]);
}
__device__ __forceinline__ int crow(int r, int hi) { return (r & 3) + 8 * (r >> 2) + 4 * hi; }

struct Params { const float* in[19]; float* out; unsigned char* ws; int ph_lo, ph_hi; };

__device__ __forceinline__ int srccol(int mode, int n) {
    if (mode == 0) return n;
    if (mode == 1) { if (n < 2048) return (n >> 7) * 192 + (n & 127); const int r = n - 2048, h = r >> 6, q = r & 63; return h * 192 + 128 + (q >> 1) + 32 * (q & 1); }
    if (mode == 2) return (n >> 7) * 256 + (n & 127);
    if (mode == 3) return (n >> 7) * 256 + 128 + (n & 127);
    if (n < 1024) return n;
    if (n < 1088) { const int r = n - 1024; return 1024 + (r >> 1) + 32 * (r & 1); }
    return -1;
}
__device__ __forceinline__ void tr_job(const float* W, int K, int Nsrc, int Ndst, bf16_t* WT, int mode, LAS float* scr, int gw, int NGW, int lane) {
    const int nblk = Ndst / 32, nitems = (K / 64) * nblk;
    for (int it = gw; it < nitems; it += NGW) {
        const int kb = it / nblk, nb = it % nblk, k0 = 64 * kb, n0 = 32 * nb;
        const int sc = srccol(mode, n0 + (lane & 31));
#pragma unroll 8
        for (int i = 0; i < 32; ++i) { const int kk = 2 * i + (lane >> 5); scr[kk * 33 + (lane & 31)] = sc >= 0 ? W[(size_t)(k0 + kk) * Nsrc + sc] : 0.f; }
        asm volatile("s_waitcnt lgkmcnt(0)" ::: "memory");
        const int c = lane & 7;
#pragma unroll
        for (int j = 0; j < 4; ++j) { const int n = (lane >> 3) + 8 * j; const LAS float* s = scr + (8 * c) * 33 + n;
            u32x4 o; o.x = cvtpk(s[0 * 33], s[1 * 33]); o.y = cvtpk(s[2 * 33], s[3 * 33]); o.z = cvtpk(s[4 * 33], s[5 * 33]); o.w = cvtpk(s[6 * 33], s[7 * 33]);
            *(u32x4*)(WT + (size_t)(n0 + n) * K + k0 + 8 * c) = o; }
        asm volatile("s_waitcnt lgkmcnt(0)" ::: "memory");
    }
}

__device__ __forceinline__ void phase_prologue(const Params& p, LAS unsigned char* lds, int vcu, int G) {
    const int tid = threadIdx.x, lane = tid & 63, wave = tid >> 6;
    const int gw = vcu * NWAVES + wave, NGW = G * NWAVES;
    LAS float* scr = (LAS float*)(lds + wave * 8704);
    unsigned char* ws = p.ws;
    tr_job(p.in[1], 2048, 1088, 1280, (bf16_t*)(ws + WS_W_MLAIN), 4, scr, gw, NGW, lane);
    tr_job(p.in[4], 512, 3072, 3072, (bf16_t*)(ws + WS_W_UQ), 1, scr, gw, NGW, lane);
    tr_job(p.in[5], 512, 4096, 2048, (bf16_t*)(ws + WS_W_UK), 2, scr, gw, NGW, lane);
    tr_job(p.in[5], 512, 4096, 2048, (bf16_t*)(ws + WS_W_UV), 3, scr, gw, NGW, lane);
    tr_job(p.in[6], 2048, 2048, 2048, (bf16_t*)(ws + WS_W_MLAO), 0, scr, gw, NGW, lane);
    tr_job(p.in[7], 2048, 8192, 8192, (bf16_t*)(ws + WS_W_HGIN), 0, scr, gw, NGW, lane);
    tr_job(p.in[10], 2048, 2048, 2048, (bf16_t*)(ws + WS_W_HGO), 0, scr, gw, NGW, lane);
    tr_job(p.in[11], 2048, 6144, 6144, (bf16_t*)(ws + WS_W_SBIN), 0, scr, gw, NGW, lane);
    tr_job(p.in[12], 2048, 2048, 2048, (bf16_t*)(ws + WS_W_SBO), 0, scr, gw, NGW, lane);
    tr_job(p.in[13], 2048, 6144, 6144, (bf16_t*)(ws + WS_W_MBIN), 0, scr, gw, NGW, lane);
    tr_job(p.in[14], 2048, 2048, 2048, (bf16_t*)(ws + WS_W_MBO), 0, scr, gw, NGW, lane);
    for (int l = 0; l < 4; ++l) {
        tr_job(p.in[17] + (size_t)l * D * FF, D, FF, FF, (bf16_t*)(ws + WS_W1) + (size_t)l * D * FF, 0, scr, gw, NGW, lane);
        tr_job(p.in[18] + (size_t)l * D * FF, FF, D, D, (bf16_t*)(ws + WS_W2) + (size_t)l * D * FF, 0, scr, gw, NGW, lane);
    }
    { const f32x4* x4 = (const f32x4*)p.in[0]; u32x2* hb = (u32x2*)(ws + WS_HB); const int gt = vcu * 512 + tid, NT = G * 512;
      for (int i = gt; i < T * D / 4; i += NT) { const f32x4 v = x4[i]; u32x2 o; o.x = cvtpk(v[0], v[1]); o.y = cvtpk(v[2], v[3]); hb[i] = o; } }
    { float* rt = (float*)(ws + WS_ROPE); const int gt = vcu * 512 + tid, NT = G * 512;
      for (int e = gt; e < SEQ * 32; e += NT) { const int pos = e >> 5, i = e & 31;
          const float inv = 1.0f / exp2f((float)i * (13.287712379549449f / 32.0f));
          const float ang = (float)pos * inv;
          const double rev = (double)ang * 0.15915494309189535; const float fr = (float)(rev - floor(rev));
          rt[2 * e] = __builtin_amdgcn_cosf(fr); rt[2 * e + 1] = __builtin_amdgcn_sinf(fr); } }
    { float* lb = (float*)(ws + WS_LB); const float* lg = p.in[8]; const int gt = vcu * 512 + tid;
      if (gt < D) { const float a0 = lg[gt], a1 = lg[D + gt], a2 = lg[2 * D + gt], a3 = lg[3 * D + gt]; const float mx = fmaxf(fmaxf(a0, a1), fmaxf(a2, a3));
          const float e0 = expf(a0 - mx), e1 = expf(a1 - mx), e2 = expf(a2 - mx), e3 = expf(a3 - mx); lb[gt] = e1 / (e0 + e1 + e2 + e3); } }
}

__device__ __forceinline__ void phase_ln(const float* Z, const float* g, const float* bt, float* H, bf16_t* HB, int vcu, int G) {
    const int tid = threadIdx.x, lane = tid & 63, wave = tid >> 6; const int gw = vcu * NWAVES + wave, NGW = G * NWAVES;
    for (int m = gw; m < T; m += NGW) {
        const f32x4* zr = (const f32x4*)(Z + (size_t)m * D) + lane; f32x4 v[8]; float s = 0.f;
#pragma unroll
        for (int j = 0; j < 8; ++j) { v[j] = zr[64 * j]; s += (v[j][0] + v[j][1]) + (v[j][2] + v[j][3]); }
        const float mean = wave_sum(s) * (1.f / D); float s2 = 0.f;
#pragma unroll
        for (int j = 0; j < 8; ++j) { v[j] = v[j] - mean; s2 += (v[j][0] * v[j][0] + v[j][1] * v[j][1]) + (v[j][2] * v[j][2] + v[j][3] * v[j][3]); }
        const float rstd = 1.f / sqrtf(wave_sum(s2) * (1.f / D) + LN_EPS);
        f32x4* hr = (f32x4*)(H + (size_t)m * D) + lane; u32x2* br = HB ? (u32x2*)(HB + (size_t)m * D) + lane : nullptr;
#pragma unroll
        for (int j = 0; j < 8; ++j) { const f32x4 gg = ((const f32x4*)g)[lane + 64 * j], bb = ((const f32x4*)bt)[lane + 64 * j]; const f32x4 y = v[j] * rstd * gg + bb;
            hr[64 * j] = y; if (br) { u32x2 o; o.x = cvtpk(y[0], y[1]); o.y = cvtpk(y[2], y[3]); br[64 * j] = o; } }
    }
}
__device__ __forceinline__ void phase_mla_prep(const bf16_t* H0, const float* qn, const float* kvn, const float* rope, bf16_t* CQN, bf16_t* CKVN, bf16_t* KR, int vcu, int G) {
    const int tid = threadIdx.x, lane = tid & 63, wave = tid >> 6; const int gw = vcu * NWAVES + wave, NGW = G * NWAVES;
    for (int m = gw; m < T; m += NGW) {
        const bf16_t* row = H0 + (size_t)m * 1280;
#pragma unroll
        for (int part = 0; part < 2; ++part) {
            const u32x4 raw = *(const u32x4*)(row + part * 512 + 8 * lane);
            float v[8]; v[0] = bflo(raw.x); v[1] = bfhi(raw.x); v[2] = bflo(raw.y); v[3] = bfhi(raw.y); v[4] = bflo(raw.z); v[5] = bfhi(raw.z); v[6] = bflo(raw.w); v[7] = bfhi(raw.w);
            float ss = 0.f;
#pragma unroll
            for (int j = 0; j < 8; ++j) ss += v[j] * v[j];
            const float r = 1.f / sqrtf(wave_sum(ss) * (1.f / 512.f) + RMS_EPS);
            const float* gp = (part ? kvn : qn) + 8 * lane; const f32x4 g0 = *(const f32x4*)gp, g1 = *(const f32x4*)(gp + 4);
            u32x4 o; o.x = cvtpk(v[0] * r * g0[0], v[1] * r * g0[1]); o.y = cvtpk(v[2] * r * g0[2], v[3] * r * g0[3]); o.z = cvtpk(v[4] * r * g1[0], v[5] * r * g1[1]); o.w = cvtpk(v[6] * r * g1[2], v[7] * r * g1[3]);
            *(u32x4*)((part ? CKVN : CQN) + (size_t)m * 512 + 8 * lane) = o;
        }
        if (lane < 32) { const unsigned raw = *(const unsigned*)(row + 1024 + 2 * lane); const float x1 = bflo(raw), x2 = bfhi(raw); const int pos = m & (SEQ - 1);
            const float c = rope[((size_t)pos * 32 + lane) * 2], s = rope[((size_t)pos * 32 + lane) * 2 + 1];
            *(unsigned*)(KR + (size_t)m * 64 + 2 * lane) = cvtpk(x1 * c - x2 * s, x2 * c + x1 * s); }
    }
}
__device__ __forceinline__ void phase_kmean(const bf16_t* K, float* KM, LAS unsigned char* lds, int vcu, int G) {
    const int tid = threadIdx.x; LAS float* red = (LAS float*)lds;
    for (int u = vcu; u < 512; u += G) { const int bh = u >> 4, blk = u & 15, b = bh >> 4, h = bh & 15;
        const int d = tid & 127, part = tid >> 7; float s = 0.f;
        const bf16_t* kp = K + (size_t)(b * SEQ + blk * 256 + part * 64) * D + h * 128 + d;
        for (int r = 0; r < 64; ++r) s += bf2f(kp[(size_t)r * D]);
        red[part * 128 + d] = s; __syncthreads();
        if (tid < 128) KM[(size_t)u * 128 + tid] = (red[tid] + red[128 + tid] + red[256 + tid] + red[384 + tid]) * (1.f / 256.f);
        __syncthreads(); }
}

struct AttnArgs { const bf16_t* Q; int ldq; const bf16_t* K; const bf16_t* Kr; const bf16_t* VT; bf16_t* O; const float* KM; };
constexpr float NEGBIG = -1.0e30f;

template <int MODE>
__device__ __forceinline__ void attn_unit(LAS unsigned char* lds, const AttnArgs& A, int b, int h, int qb) {
    constexpr int DK = MODE == 0 ? 192 : 128, ND = DK / 16, CPK = DK / 8, KP = DK * 2, KTB = 64 * KP, VP = 128, VTB = 128 * VP, BUF = KTB + VTB, NKC = (64 * CPK) / 512, MISC = 2 * BUF;
    const int tid = threadIdx.x, lane = tid & 63, wave = __builtin_amdgcn_readfirstlane(tid >> 6), r32 = lane & 31, hi = lane >> 5;
    const int q0 = qb * 256, qw0 = q0 + wave * 32, qi = qw0 + r32;
    const size_t tokq = (size_t)b * SEQ + qi;
    bf16x8 qf[ND];
#pragma unroll
    for (int d0 = 0; d0 < 8; ++d0) qf[d0] = *(const bf16x8*)(A.Q + tokq * A.ldq + h * 128 + 16 * d0 + 8 * hi);
    LAS unsigned char* qlds = lds + MISC + (MODE == 2 ? 8192 : 0) + wave * 8192 + lane * 16;
    if constexpr (MODE != 1) {
#pragma unroll
        for (int d0 = 0; d0 < 8; ++d0) *(LAS bf16x8*)(qlds + d0 * 1024) = qf[d0];
    }
    const bf16_t* qrp = A.Q + tokq * A.ldq + 2048 + h * 64 + 8 * hi;
    unsigned sel = 0u, umask = 0u; int nT = (q0 + 256) / 64;
    if constexpr (MODE == 2) {
        const int blk = qb;
        LAS unsigned* um = (LAS unsigned*)(lds + MISC); LAS float* km = (LAS float*)(lds + MISC + 64);
        for (int i = tid; i < blk * 128; i += 512) km[i] = A.KM[(size_t)((b * 16 + h) * 16) * 128 + i];
        if (tid == 0) um[0] = 0u;
        __syncthreads();
        float v0 = -INFINITY, v1 = -INFINITY, v2 = -INFINITY; int i0 = -1, i1 = -1, i2 = -1;
        for (int j = 0; j < blk; ++j) {
            float g = 0.f;
#pragma unroll
            for (int d0 = 0; d0 < 8; ++d0)
#pragma unroll
                for (int jj = 0; jj < 8; ++jj) g += bf2f((unsigned short)qf[d0][jj]) * km[j * 128 + 16 * d0 + 8 * hi + jj];
            g += xhalf(g);
            if (g > v0) { v2 = v1; i2 = i1; v1 = v0; i1 = i0; v0 = g; i0 = j; }
            else if (g > v1) { v2 = v1; i2 = i1; v1 = g; i1 = j; }
            else if (g > v2) { v2 = g; i2 = j; }
        }
        if (i0 >= 0) sel |= 1u << i0; if (i1 >= 0) sel |= 1u << i1; if (i2 >= 0) sel |= 1u << i2;
        if (sel) atomicOr((unsigned*)um, sel);
        __syncthreads();
        umask = um[0];
        nT = 4 + 4 * __builtin_popcount(umask);
    }
    auto tile_base = [&](int n) -> int {
        if constexpr (MODE == 0) return 64 * n;
        else if constexpr (MODE == 1) return 64 * (nT - 1 - n);
        else { if (n < 4) return q0 + 64 * n; unsigned m = umask; const int k = (n - 4) >> 2; for (int i = 0; i < k; ++i) m &= m - 1; return 256 * __builtin_ctz(m) + 64 * ((n - 4) & 3); }
    };
#define ATT_DMA(kbase_, bufoff_) do { const int kb_ = (kbase_); const int bo_ = (bufoff_); \
        _Pragma("unroll") for (int i_ = 0; i_ < NKC; ++i_) { const int piece_ = wave + 8 * i_; const int P_ = piece_ * 64 + lane, key_ = P_ / CPK, cpp_ = P_ - key_ * CPK; \
            const int cp_ = cpp_ ^ (DK == 128 ? (key_ & 15) : ((key_ >> 1) & 7)); const size_t tok_ = (size_t)b * SEQ + kb_ + key_; \
            const bf16_t* src_ = (MODE == 0 && cp_ >= 16) ? A.Kr + tok_ * 64 + (cp_ - 16) * 8 : A.K + tok_ * 2048 + h * 128 + cp_ * 8; \
            __builtin_amdgcn_global_load_lds((const unsigned*)src_, (LAS unsigned*)(lds + bo_ + piece_ * 1024), 16, 0, 0); } \
        _Pragma("unroll") for (int i_ = 0; i_ < 2; ++i_) { const int piece_ = wave + 8 * i_; const int P_ = piece_ * 64 + lane, d_ = P_ >> 3, cp_ = (P_ & 7) ^ (d_ & 7); \
            const bf16_t* src_ = A.VT + (size_t)(h * 128 + d_) * T + (size_t)b * SEQ + kb_ + cp_ * 8; \
            __builtin_amdgcn_global_load_lds((const unsigned*)src_, (LAS unsigned*)(lds + bo_ + KTB + piece_ * 1024), 16, 0, 0); } } while (0)
#define ATT_WAIT() do { asm volatile("s_waitcnt vmcnt(0)" ::: "memory"); __syncthreads(); } while (0)

    f32x16 o[4];
#pragma unroll
    for (int i = 0; i < 4; ++i)
#pragma unroll
        for (int r = 0; r < 16; ++r) o[i][r] = 0.f;
    float mrun = NEGBIG, lrun = 0.f, carry = 0.f;

    ATT_DMA(tile_base(0), 0); ATT_WAIT();
    for (int n = 0; n < nT; ++n) {
        const int kbase = tile_base(n), bufoff = (n & 1) * BUF;
        if (n + 1 < nT) ATT_DMA(tile_base(n + 1), ((n + 1) & 1) * BUF);
        bool active, causal = false, off = false;
        if constexpr (MODE == 0) { active = kbase <= qw0 + 31; causal = kbase + 63 > qw0; }
        else if constexpr (MODE == 1) { active = kbase <= qw0 + 31; }
        else { if (n < 4) { active = kbase <= qw0 + 31; causal = kbase + 63 > qw0; }
               else { const int jb = kbase >> 8; off = ((sel >> jb) & 1u) == 0u; active = __ballot(!off) != 0ull; } }
        if (active) {
            f32x16 s0, s1;
#pragma unroll
            for (int r = 0; r < 16; ++r) { s0[r] = 0.f; s1[r] = 0.f; }
            const LAS unsigned char* kb = lds + bufoff + r32 * KP; const int fxk = DK == 128 ? (r32 & 15) : ((r32 >> 1) & 7);
            bf16x8 qr[4];
            if constexpr (MODE == 0) { const bf16_t* qq = qrp; asm volatile("" : "+v"(qq));
#pragma unroll
                for (int e = 0; e < 4; ++e) qr[e] = *(const bf16x8*)(qq + 16 * e); }
#pragma unroll
            for (int d0 = 0; d0 < ND; ++d0) { const int ko = ((2 * d0 + hi) ^ fxk) << 4; const bf16x8 k0 = *(const LAS bf16x8*)(kb + ko), k1 = *(const LAS bf16x8*)(kb + 32 * KP + ko);
                bf16x8 qv;
                if constexpr (MODE != 1) { if (d0 < 8) qv = *(const LAS bf16x8*)(qlds + d0 * 1024); else qv = qr[d0 & 3]; } else qv = qf[d0];
                s0 = MFMA32(k0, qv, s0); s1 = MFMA32(k1, qv, s1); }
            bf16x8 pb[4];
            if constexpr (MODE == 1) {
                float X[32], LZ[32];
#pragma unroll
                for (int i = 0; i < 32; ++i) { const float z = i < 16 ? s0[i & 15] : s1[i & 15]; const int key = kbase + 8 * (i >> 2) + 4 * hi + (i & 3); const bool strict = key < qi;
                    const float u = __builtin_amdgcn_exp2f(-fabsf(z)); const float sp = fmaxf(z, 0.f) + __builtin_amdgcn_logf(1.f + u);
                    X[i] = strict ? -sp : 0.f; LZ[i] = strict ? (z - sp) : NEGBIG; }
                float gs[8], og[8];
#pragma unroll
                for (int g = 0; g < 8; ++g) { gs[g] = (X[4 * g] + X[4 * g + 1]) + (X[4 * g + 2] + X[4 * g + 3]); og[g] = xhalf(gs[g]); }
                float run = carry;
#pragma unroll
                for (int g = 7; g >= 0; --g) { const float a3 = run + (hi ? 0.f : og[g]); const float a2 = a3 + X[4 * g + 3], a1 = a2 + X[4 * g + 2], a0 = a1 + X[4 * g + 1];
                    LZ[4 * g + 3] = __builtin_amdgcn_exp2f(LZ[4 * g + 3] + a3); LZ[4 * g + 2] = __builtin_amdgcn_exp2f(LZ[4 * g + 2] + a2);
                    LZ[4 * g + 1] = __builtin_amdgcn_exp2f(LZ[4 * g + 1] + a1); LZ[4 * g] = __builtin_amdgcn_exp2f(LZ[4 * g] + a0);
                    run += gs[g] + og[g]; }
                carry = run;
#pragma unroll
                for (int c = 0; c < 4; ++c) { u32x4 w; w.x = cvtpk(LZ[8 * c], LZ[8 * c + 1]); w.y = cvtpk(LZ[8 * c + 2], LZ[8 * c + 3]); w.z = cvtpk(LZ[8 * c + 4], LZ[8 * c + 5]); w.w = cvtpk(LZ[8 * c + 6], LZ[8 * c + 7]); pb[c] = __builtin_bit_cast(bf16x8, w); }
            } else {
                if (causal) {
#pragma unroll
                    for (int r = 0; r < 16; ++r) { const int key = kbase + crow(r, hi); if (key > qi) s0[r] = NEGBIG; if (key + 32 > qi) s1[r] = NEGBIG; }
                }
                if (MODE == 2 && off) {
#pragma unroll
                    for (int r = 0; r < 16; ++r) { s0[r] = NEGBIG; s1[r] = NEGBIG; }
                }
                float mx = fmaxf(s0[0], s1[0]);
#pragma unroll
                for (int r = 1; r < 16; ++r) mx = fmaxf(mx, fmaxf(s0[r], s1[r]));
                mx = fmaxf(mx, xhalf(mx));
                const float mnew = fmaxf(mrun, mx), alpha = __builtin_amdgcn_exp2f(mrun - mnew); mrun = mnew;
                float ls = 0.f;
#pragma unroll
                for (int r = 0; r < 16; ++r) { s0[r] = __builtin_amdgcn_exp2f(s0[r] - mnew); s1[r] = __builtin_amdgcn_exp2f(s1[r] - mnew); ls += s0[r] + s1[r]; }
                lrun = lrun * alpha + ls;
#pragma unroll
                for (int i = 0; i < 4; ++i)
#pragma unroll
                    for (int r = 0; r < 16; ++r) o[i][r] *= alpha;
#pragma unroll
                for (int c = 0; c < 4; ++c) { u32x4 w;
                    if (c < 2) { w.x = cvtpk(s0[8 * c], s0[8 * c + 1]); w.y = cvtpk(s0[8 * c + 2], s0[8 * c + 3]); w.z = cvtpk(s0[8 * c + 4], s0[8 * c + 5]); w.w = cvtpk(s0[8 * c + 6], s0[8 * c + 7]); }
                    else { const int cc = c - 2; w.x = cvtpk(s1[8 * cc], s1[8 * cc + 1]); w.y = cvtpk(s1[8 * cc + 2], s1[8 * cc + 3]); w.z = cvtpk(s1[8 * cc + 4], s1[8 * cc + 5]); w.w = cvtpk(s1[8 * cc + 6], s1[8 * cc + 7]); }
                    pb[c] = __builtin_bit_cast(bf16x8, w); }
            }
            const LAS unsigned char* vb = lds + bufoff + KTB + r32 * VP + hi * 8; const int fxv = r32 & 7;
#pragma unroll
            for (int db = 0; db < 4; ++db)
#pragma unroll
                for (int c = 0; c < 4; ++c) { const s16x4 lo = *(const LAS s16x4*)(vb + db * 32 * VP + (((2 * c) ^ fxv) << 4)), h4 = *(const LAS s16x4*)(vb + db * 32 * VP + (((2 * c + 1) ^ fxv) << 4));
                    const bf16x8 vf = {lo[0], lo[1], lo[2], lo[3], h4[0], h4[1], h4[2], h4[3]};
                    o[db] = MFMA32(vf, pb[c], o[db]); }
        }
        ATT_WAIT();
    }
#undef ATT_DMA
#undef ATT_WAIT
    float inv = 1.f;
    if constexpr (MODE != 1) { const float lt = lrun + xhalf(lrun); inv = 1.f / lt; }
    bf16_t* orow = A.O + tokq * D + h * 128 + 4 * hi;
#pragma unroll
    for (int db = 0; db < 4; ++db)
#pragma unroll
        for (int g = 0; g < 4; ++g) { u32x2 w; w.x = cvtpk(o[db][4 * g] * inv, o[db][4 * g + 1] * inv); w.y = cvtpk(o[db][4 * g + 2] * inv, o[db][4 * g + 3] * inv);
            *(u32x2*)(orow + 32 * db + 8 * g) = w; }
}

template <int MODE>
__device__ __forceinline__ void phase_attn(LAS unsigned char* lds, const AttnArgs& A, int vcu, int G) {
    if constexpr (MODE == 2) { for (int u = vcu; u < 512; u += G) { const int blk = 15 - (u >> 5), bh = u & 31; attn_unit<2>(lds, A, bh >> 4, bh & 15, blk); } }
    else { for (int it = vcu; it < 256; it += G) { const int bh = it >> 3, s = it & 7; attn_unit<MODE>(lds, A, bh >> 4, bh & 15, 15 - s); attn_unit<MODE>(lds, A, bh >> 4, bh & 15, s); } }
}

__device__ __forceinline__ void hgrn_h1_unit(LAS unsigned char* lds, const bf16_t* BIG, const float* lb, bf16_t* QT, float* OI, bf16_t* DELTA, float* DEC, int unit) {
    constexpr int QA = 0, KA0 = 17408, KA1 = 26112, KHT = 43520, VTL = 60928, SEGO = 78336, RP = 272, VP = 136;
    const int tid = threadIdx.x, lane = tid & 63, wave = __builtin_amdgcn_readfirstlane(tid >> 6), r32 = lane & 31, hi = lane >> 5;
    const int bh = unit >> 6, c = unit & 63, b = bh >> 4, h = bh & 15;
    const int d = tid & 127, part = tid >> 7;
    const size_t tok0 = (size_t)b * SEQ + c * 64 + part * 16;
    LAS float* SEG = (LAS float*)(lds + SEGO);
    const float lbd = lb[h * 128 + d], oml = 1.f - lbd;
    float qv[16], bb[16], kv[16]; float run = 0.f; unsigned vp[8];
#pragma unroll
    for (int i = 0; i < 16; ++i) { const bf16_t* row = BIG + (tok0 + i) * 8192 + h * 128 + d;
        const float q = bf2f(row[0]), fp = bf2f(row[2048]); const unsigned short vraw = row[4096];
        const float e = __expf(-fp); const float sig = 1.f / (1.f + e); const float f = lbd + oml * sig;
        const float lf = __logf(f); const float k = oml * (1.f - sig);
        run += lf; bb[i] = run; qv[i] = q; kv[i] = k;
        if (i & 1) vp[i >> 1] |= ((unsigned)vraw) << 16; else vp[i >> 1] = vraw; }
    SEG[part * 128 + d] = run;
    { LAS unsigned char* vt = lds + VTL + d * VP + part * 32;
#pragma unroll
      for (int j = 0; j < 4; ++j) *(LAS u32x2*)(vt + 8 * j) = (u32x2){vp[2 * j], vp[2 * j + 1]}; }
    __syncthreads();
    const float s0 = SEG[d], s1 = SEG[128 + d], s2 = SEG[256 + d], s3 = SEG[384 + d];
    const float prefix = part == 0 ? 0.f : part == 1 ? s0 : part == 2 ? s0 + s1 : (s0 + s1) + s2;
    const float bend = ((s0 + s1) + s2) + s3, beta1 = s0 + s1, betaI = part >= 2 ? beta1 : 0.f;
    unsigned khp[8];
#pragma unroll
    for (int i = 0; i < 16; ++i) { const float bt = prefix + bb[i]; const int t = part * 16 + i;
        *(LAS bf16_t*)(lds + QA + t * RP + 2 * d) = f2bf(qv[i] * __expf(bt - betaI));
        QT[(tok0 + i) * D + h * 128 + d] = f2bf(qv[i] * __expf(bt));
        if (part < 2) *(LAS bf16_t*)(lds + KA0 + t * RP + 2 * d) = f2bf(kv[i] * __expf(fminf(-bt, 80.f)));
        *(LAS bf16_t*)(lds + KA1 + t * RP + 2 * d) = f2bf(kv[i] * __expf(fminf(beta1 - bt, 80.f)));
        const unsigned short kh = f2bf(kv[i] * __expf(bend - bt));
        if (i & 1) khp[i >> 1] |= ((unsigned)kh) << 16; else khp[i >> 1] = kh; }
    { LAS unsigned char* kt = lds + KHT + d * VP + part * 32;
#pragma unroll
      for (int j = 0; j < 4; ++j) *(LAS u32x2*)(kt + 8 * j) = (u32x2){khp[2 * j], khp[2 * j + 1]}; }
    if (part == 0) DEC[(size_t)unit * 128 + d] = __expf(bend);
    __syncthreads();
    const int tg = wave & 1, dblk = wave >> 1;
    f32x16 sA0, sA1;
#pragma unroll
    for (int r = 0; r < 16; ++r) { sA0[r] = 0.f; sA1[r] = 0.f; }
    { const LAS unsigned char* qa = lds + QA + (32 * tg + r32) * RP + 16 * hi; const LAS unsigned char* ka = lds + (tg ? KA1 : KA0) + r32 * RP + 16 * hi;
#pragma unroll
      for (int d0 = 0; d0 < 8; ++d0) { const bf16x8 qfr = *(const LAS bf16x8*)(qa + 32 * d0); const bf16x8 k0 = *(const LAS bf16x8*)(ka + 32 * d0);
          sA0 = MFMA32(k0, qfr, sA0);
          if (tg) { const bf16x8 k1 = *(const LAS bf16x8*)(ka + 32 * RP + 32 * d0); sA1 = MFMA32(k1, qfr, sA1); } } }
    if (tg == 0) {
#pragma unroll
        for (int r = 0; r < 16; ++r) if (crow(r, hi) > r32) sA0[r] = 0.f;
    } else {
#pragma unroll
        for (int r = 0; r < 16; ++r) if (crow(r, hi) > r32) sA1[r] = 0.f;
    }
    bf16x8 pb[4];
#pragma unroll
    for (int cc = 0; cc < 2; ++cc) { u32x4 w; w.x = cvtpk(sA0[8 * cc], sA0[8 * cc + 1]); w.y = cvtpk(sA0[8 * cc + 2], sA0[8 * cc + 3]); w.z = cvtpk(sA0[8 * cc + 4], sA0[8 * cc + 5]); w.w = cvtpk(sA0[8 * cc + 6], sA0[8 * cc + 7]); pb[cc] = __builtin_bit_cast(bf16x8, w);
        u32x4 w2; w2.x = cvtpk(sA1[8 * cc], sA1[8 * cc + 1]); w2.y = cvtpk(sA1[8 * cc + 2], sA1[8 * cc + 3]); w2.z = cvtpk(sA1[8 * cc + 4], sA1[8 * cc + 5]); w2.w = cvtpk(sA1[8 * cc + 6], sA1[8 * cc + 7]); pb[2 + cc] = __builtin_bit_cast(bf16x8, w2); }
    bf16x8 vf[4];
    { const LAS unsigned char* vb = lds + VTL + (32 * dblk + r32) * VP + 8 * hi;
#pragma unroll
      for (int cc = 0; cc < 4; ++cc) { const s16x4 lo = *(const LAS s16x4*)(vb + 32 * cc), h4 = *(const LAS s16x4*)(vb + 32 * cc + 16); vf[cc] = (bf16x8){lo[0], lo[1], lo[2], lo[3], h4[0], h4[1], h4[2], h4[3]}; } }
    f32x16 oi;
#pragma unroll
    for (int r = 0; r < 16; ++r) oi[r] = 0.f;
    oi = MFMA32(vf[0], pb[0], oi); oi = MFMA32(vf[1], pb[1], oi);
    if (tg) { oi = MFMA32(vf[2], pb[2], oi); oi = MFMA32(vf[3], pb[3], oi); }
    { f32x4* op = (f32x4*)(OI + ((size_t)(unit * 8 + wave) * 64 + lane) * 16);
#pragma unroll
      for (int j = 0; j < 4; ++j) op[j] = (f32x4){oi[4 * j], oi[4 * j + 1], oi[4 * j + 2], oi[4 * j + 3]}; }
#pragma unroll
    for (int dbi = 0; dbi < 2; ++dbi) { const int db = 2 * tg + dbi; f32x16 dl;
#pragma unroll
        for (int r = 0; r < 16; ++r) dl[r] = 0.f;
        const LAS unsigned char* kb = lds + KHT + (32 * db + r32) * VP + 8 * hi;
#pragma unroll
        for (int cc = 0; cc < 4; ++cc) { const s16x4 lo = *(const LAS s16x4*)(kb + 32 * cc), h4 = *(const LAS s16x4*)(kb + 32 * cc + 16); const bf16x8 kf = {lo[0], lo[1], lo[2], lo[3], h4[0], h4[1], h4[2], h4[3]};
            dl = MFMA32(vf[cc], kf, dl); }
        bf16_t* dp = DELTA + ((size_t)unit * 128 + 32 * dblk) * 128 + 32 * db + r32;
#pragma unroll
        for (int r = 0; r < 16; ++r) dp[(size_t)crow(r, hi) * 128] = f2bf(dl[r]); }
    __syncthreads();
}
__device__ __forceinline__ void phase_hgrn_scan(bf16_t* DELTA, const float* DEC, int vcu, int G) {
    const int gt = vcu * 512 + threadIdx.x, NT = G * 512;
    for (int e = gt; e < 32 * 128 * 32; e += NT) { const int bh = e >> 12, v = (e >> 5) & 127, d4 = e & 31;
        float S0 = 0.f, S1 = 0.f, S2 = 0.f, S3 = 0.f;
#pragma unroll 8
        for (int c = 0; c < 64; ++c) { const size_t unit = (size_t)bh * 64 + c; u32x2* ptr = (u32x2*)(DELTA + (unit * 128 + v) * 128 + 4 * d4);
            const u32x2 raw = *ptr; const f32x4 dc = *(const f32x4*)(DEC + unit * 128 + 4 * d4);
            u32x2 w; w.x = cvtpk(S0, S1); w.y = cvtpk(S2, S3); *ptr = w;
            S0 = dc[0] * S0 + bflo(raw.x); S1 = dc[1] * S1 + bfhi(raw.x); S2 = dc[2] * S2 + bflo(raw.y); S3 = dc[3] * S3 + bfhi(raw.y); } }
}
__device__ __forceinline__ void hgrn_h3_unit(LAS unsigned char* lds, const bf16_t* BIG, const bf16_t* QT, const float* OI, const bf16_t* ST, const float* onorm, bf16_t* GO, int unit) {
    const int tid = threadIdx.x, lane = tid & 63, wave = __builtin_amdgcn_readfirstlane(tid >> 6), r32 = lane & 31, hi = lane >> 5;
    const int bh = unit >> 6, c = unit & 63, b = bh >> 4, h = bh & 15, tg = wave & 1, dblk = wave >> 1;
    const size_t tok = (size_t)b * SEQ + c * 64 + 32 * tg + r32;
    LAS float* red = (LAS float*)lds;
    f32x16 o;
    { const f32x4* op = (const f32x4*)(OI + ((size_t)(unit * 8 + wave) * 64 + lane) * 16);
#pragma unroll
      for (int j = 0; j < 4; ++j) { const f32x4 t4 = op[j]; o[4 * j] = t4[0]; o[4 * j + 1] = t4[1]; o[4 * j + 2] = t4[2]; o[4 * j + 3] = t4[3]; } }
    const bf16_t* sp = ST + ((size_t)unit * 128 + 32 * dblk + r32) * 128 + 8 * hi; const bf16_t* qp = QT + tok * D + h * 128 + 8 * hi;
#pragma unroll
    for (int d0 = 0; d0 < 8; ++d0) { const bf16x8 sf = *(const bf16x8*)(sp + 16 * d0), qfr = *(const bf16x8*)(qp + 16 * d0); o = MFMA32(sf, qfr, o); }
    float ss = 0.f;
#pragma unroll
    for (int r = 0; r < 16; ++r) ss += o[r] * o[r];
    ss += xhalf(ss);
    if (hi == 0) red[dblk * 64 + 32 * tg + r32] = ss;
    __syncthreads();
    const int t = 32 * tg + r32; const float tot = (red[t] + red[64 + t]) + (red[128 + t] + red[192 + t]);
    const float rinv = 1.f / sqrtf(tot * (1.f / 128.f) + RMS_EPS);
#pragma unroll
    for (int g = 0; g < 4; ++g) { const int v0 = 32 * dblk + 8 * g + 4 * hi; const f32x4 gn = *(const f32x4*)(onorm + h * 128 + v0);
        const u32x2 graw = *(const u32x2*)(BIG + tok * 8192 + 6144 + h * 128 + v0); const float g0 = bflo(graw.x), g1 = bfhi(graw.x), g2 = bflo(graw.y), g3 = bfhi(graw.y);
        const float y0 = o[4 * g] * rinv * gn[0] * (g0 / (1.f + __expf(-g0))), y1 = o[4 * g + 1] * rinv * gn[1] * (g1 / (1.f + __expf(-g1)));
        const float y2 = o[4 * g + 2] * rinv * gn[2] * (g2 / (1.f + __expf(-g2))), y3 = o[4 * g + 3] * rinv * gn[3] * (g3 / (1.f + __expf(-g3)));
        u32x2 w; w.x = cvtpk(y0, y1); w.y = cvtpk(y2, y3); *(u32x2*)(GO + tok * D + h * 128 + v0) = w; }
    __syncthreads();
}

#define XB_TMO      128
#define XB_XCNT(j)  (256  + 64 * (j))
#define XB_XSUB(j)  (1280 + 64 * (j))
#define XB_XGEN(j)  (2304 + 64 * (j))
#define XB_TOP      3328
#define XB_TOPGEN   3392
#define XCD_BAR_WORDS 3456
#define XB_SPIN_CAP (1u << 18)

__device__ __forceinline__ unsigned xb_ld(unsigned* p)              { return __hip_atomic_load(p, __ATOMIC_RELAXED, __HIP_MEMORY_SCOPE_AGENT); }
__device__ __forceinline__ unsigned xb_add(unsigned* p, unsigned v) { return __hip_atomic_fetch_add(p, v, __ATOMIC_RELAXED, __HIP_MEMORY_SCOPE_AGENT); }
__device__ __forceinline__ unsigned xb_xcc_id() { return (unsigned)__builtin_amdgcn_s_getreg((3 << 11) | 20) & 0xFu; }
#define XB_SPIN(cond, bar) do { unsigned _sp = 0; while (cond) { __builtin_amdgcn_s_sleep(1); \
    if ((++_sp & 255u) == 0u) { if (xb_ld(&(bar)[XB_TMO])) break; if (_sp > XB_SPIN_CAP) { atomicAdd(&(bar)[XB_TMO], 1u); break; } } } } while (0)

struct XcdBarrier {
    unsigned* bar; unsigned x;
    volatile LAS unsigned* st;
};

__device__ __forceinline__ XcdBarrier xcd_barrier_post(unsigned* bar, volatile LAS unsigned* st) {
    XcdBarrier b; b.bar = bar; b.x = xb_xcc_id(); b.st = st;
    if (threadIdx.x == 0) (void)xb_add(&bar[XB_XCNT(b.x)], 1u);
    return b;
}
__device__ __forceinline__ void xcd_barrier_complete(unsigned* bar, unsigned x, unsigned& nloc, unsigned& nx) {
    const unsigned G = gridDim.x * gridDim.y * gridDim.z;
    unsigned sum, cnt, mine, sp = 0u;
    for (;;) {
        sum = 0u; cnt = 0u; mine = 0u;
#pragma unroll
        for (unsigned j = 0; j < 16; ++j) { const unsigned c = xb_ld(&bar[XB_XCNT(j)]); sum += c; cnt += (c > 0u) ? 1u : 0u; mine = (j == x) ? c : mine; }
        if (sum == G) break;
        __builtin_amdgcn_s_sleep(1);
        if ((++sp & 255u) == 0u) { if (xb_ld(&bar[XB_TMO])) break; if (sp > XB_SPIN_CAP) { atomicAdd(&bar[XB_TMO], 1u); break; } }
    }
    nloc = mine > 0u ? mine : 1u; nx = cnt > 0u ? cnt : 1u;
}

__device__ __forceinline__ void xcd_barrier(const XcdBarrier& b) {
    asm volatile("s_waitcnt vmcnt(0)" ::: "memory");
    __syncthreads();
    if (threadIdx.x == 0) {
        unsigned* bar = b.bar;
        __builtin_amdgcn_s_waitcnt(0);
        unsigned nloc = b.st[0], nx = b.st[1];
        if (nloc == 0u) { xcd_barrier_complete(bar, b.x, nloc, nx); b.st[0] = nloc; b.st[1] = nx; }
        const unsigned old = xb_add(&bar[XB_XSUB(b.x)], 1u);
        const unsigned gen = old / nloc;
        if (old + 1u == (gen + 1u) * nloc) {
            __builtin_amdgcn_fence(__ATOMIC_RELEASE, "agent");
            asm volatile("s_waitcnt vmcnt(0)" ::: "memory");
            const unsigned og = xb_add(&bar[XB_TOP], 1u);
            const unsigned tg = og / nx;
            if (og + 1u == (tg + 1u) * nx) xb_add(&bar[XB_TOPGEN], 1u);
            else XB_SPIN(xb_ld(&bar[XB_TOPGEN]) == tg, bar);
            __builtin_amdgcn_fence(__ATOMIC_ACQUIRE, "agent");
            xb_add(&bar[XB_XGEN(b.x)], 1u);
            asm volatile("s_waitcnt vmcnt(0)" ::: "memory");
        } else {
            XB_SPIN(xb_ld(&bar[XB_XGEN(b.x)]) == gen, bar);
            __builtin_amdgcn_fence(__ATOMIC_ACQUIRE, "agent");
            asm volatile("s_waitcnt vmcnt(0)" ::: "memory");
        }
    }
    __syncthreads();
}

template <class Epi>
__device__ __forceinline__ void run_gemm(LAS unsigned char* lds, const bf16_t* A, const bf16_t* Bt, int M, int N, int K, const Epi& E, int G) {
    pg8::Gemm g{A, Bt, M, N, K}; pg8::StaticOrder S; S.init(M, N, G, (int)blockIdx.x);
    pg8::gemm_phase<Epi, pg8::StaticOrder, true, true>((PG8_LAS unsigned char*)lds, g, S, E);
}
__device__ __forceinline__ pg8::EpiStore epi_plain(bf16_t* O, int ldc, float scale = 1.f, int act = 0) {
    pg8::EpiStore e; e.O = O; e.ldc = ldc; e.scale = scale; e.act = act; e.O2 = nullptr; e.split_col = 1 << 30; e.ldc2 = 0; e.scale2 = 1.f; e.rope = nullptr; e.rope_col = 1 << 30; return e;
}

__global__ void __launch_bounds__(512) fwd_megakernel(Params p) {
    extern __shared__ __attribute__((aligned(16))) unsigned char lds_raw[];
    LAS unsigned char* lds = (LAS unsigned char*)lds_raw;
    cg::grid_group grid = cg::this_grid();
    const int G = gridDim.x, bx = blockIdx.x; const int vcu = (G % 8 == 0) ? (bx % 8) * (G / 8) + bx / 8 : bx;
    unsigned char* ws = p.ws;
    volatile LAS unsigned* bst = (volatile LAS unsigned*)(lds + LDS_BYTES - 64);
    if (threadIdx.x < 2) bst[threadIdx.x] = 0u;
    unsigned* barw = (unsigned*)ws;
    if (bx == 0) for (int i = threadIdx.x; i < XCD_BAR_WORDS; i += 512) barw[i] = 0u;
    __syncthreads();
    grid.sync();
    XcdBarrier bar = xcd_barrier_post(barw, bst);
#define PH_BEGIN {
#define PH_END   xcd_barrier(bar); }
    float* H32 = (float*)(ws + WS_H32); bf16_t* HB = (bf16_t*)(ws + WS_HB); bf16_t* BIG = (bf16_t*)(ws + WS_BIG);
    const float* ln_g = p.in[15]; const float* ln_b = p.in[16];
    bf16_t* VT = (bf16_t*)(ws + WS_VT); bf16_t* OB = (bf16_t*)(ws + WS_O);

    PH_BEGIN phase_prologue(p, lds, vcu, G); PH_END

    PH_BEGIN run_gemm(lds, HB, (const bf16_t*)(ws + WS_W_MLAIN), T, 1280, D, epi_plain((bf16_t*)(ws + WS_H0), 1280), G); PH_END
    PH_BEGIN phase_mla_prep((const bf16_t*)(ws + WS_H0), p.in[2], p.in[3], (const float*)(ws + WS_ROPE), (bf16_t*)(ws + WS_CQN), (bf16_t*)(ws + WS_CKVN), (bf16_t*)(ws + WS_KR), vcu, G); PH_END
    PH_BEGIN {
        pg8::EpiStore eq = epi_plain((bf16_t*)(ws + WS_Q3), 3072, 0.07216878364870322f * LOG2E); eq.rope = (const float*)(ws + WS_ROPE); eq.rope_col = 2048;
        run_gemm(lds, (const bf16_t*)(ws + WS_CQN), (const bf16_t*)(ws + WS_W_UQ), T, 3072, 512, eq, G);
        run_gemm(lds, (const bf16_t*)(ws + WS_CKVN), (const bf16_t*)(ws + WS_W_UK), T, 2048, 512, epi_plain((bf16_t*)(ws + WS_KN), 2048), G);
        run_gemm(lds, (const bf16_t*)(ws + WS_W_UV), (const bf16_t*)(ws + WS_CKVN), 2048, T, 512, epi_plain(VT, T), G);
    } PH_END
    PH_BEGIN { AttnArgs a{(const bf16_t*)(ws + WS_Q3), 3072, (const bf16_t*)(ws + WS_KN), (const bf16_t*)(ws + WS_KR), VT, OB, nullptr}; phase_attn<0>(lds, a, vcu, G); } PH_END
    PH_BEGIN { pg8::EpiRes e{p.in[0], H32, D, ALPHA}; run_gemm(lds, OB, (const bf16_t*)(ws + WS_W_MLAO), T, D, D, e, G); } PH_END

#define MLP_BLOCK(L, OUT32, OUTB) \
    PH_BEGIN phase_ln(H32, ln_g + ((L) * 2 + 0) * D, ln_b + ((L) * 2 + 0) * D, H32, HB, vcu, G); PH_END \
    PH_BEGIN run_gemm(lds, HB, (const bf16_t*)(ws + WS_W1) + (size_t)(L) * D * FF, T, FF, D, epi_plain(BIG, FF, 1.f, 1), G); PH_END \
    PH_BEGIN { pg8::EpiRes e{H32, H32, D, ALPHA}; run_gemm(lds, BIG, (const bf16_t*)(ws + WS_W2) + (size_t)(L) * D * FF, T, D, FF, e, G); } PH_END \
    PH_BEGIN phase_ln(H32, ln_g + ((L) * 2 + 1) * D, ln_b + ((L) * 2 + 1) * D, (OUT32), (OUTB), vcu, G); PH_END

    MLP_BLOCK(0, H32, HB)

    PH_BEGIN run_gemm(lds, HB, (const bf16_t*)(ws + WS_W_HGIN), T, 8192, D, epi_plain(BIG, 8192), G); PH_END
    PH_BEGIN for (int u = vcu; u < 2048; u += G) hgrn_h1_unit(lds, BIG, (const float*)(ws + WS_LB), (bf16_t*)(ws + WS_QT), (float*)(ws + WS_OI), (bf16_t*)(ws + WS_DELTA), (float*)(ws + WS_DEC), u); PH_END
    PH_BEGIN phase_hgrn_scan((bf16_t*)(ws + WS_DELTA), (const float*)(ws + WS_DEC), vcu, G); PH_END
    PH_BEGIN for (int u = vcu; u < 2048; u += G) hgrn_h3_unit(lds, BIG, (const bf16_t*)(ws + WS_QT), (const float*)(ws + WS_OI), (const bf16_t*)(ws + WS_DELTA), p.in[9], (bf16_t*)(ws + WS_GO), u); PH_END
    PH_BEGIN { pg8::EpiRes e{H32, H32, D, ALPHA}; run_gemm(lds, (const bf16_t*)(ws + WS_GO), (const bf16_t*)(ws + WS_W_HGO), T, D, D, e, G); } PH_END
    MLP_BLOCK(1, H32, HB)

    PH_BEGIN {
        pg8::EpiStore eq = epi_plain((bf16_t*)(ws + WS_Q), 2048, 0.08838834764831845f * LOG2E); eq.O2 = (bf16_t*)(ws + WS_K); eq.split_col = 2048; eq.ldc2 = 2048; eq.scale2 = 1.f;
        run_gemm(lds, HB, (const bf16_t*)(ws + WS_W_SBIN), T, 4096, D, eq, G);
        run_gemm(lds, (const bf16_t*)(ws + WS_W_SBIN) + (size_t)4096 * D, HB, 2048, T, D, epi_plain(VT, T), G);
    } PH_END
    PH_BEGIN { AttnArgs a{(const bf16_t*)(ws + WS_Q), 2048, (const bf16_t*)(ws + WS_K), nullptr, VT, OB, nullptr}; phase_attn<1>(lds, a, vcu, G); } PH_END
    PH_BEGIN { pg8::EpiRes e{H32, H32, D, ALPHA}; run_gemm(lds, OB, (const bf16_t*)(ws + WS_W_SBO), T, D, D, e, G); } PH_END
    MLP_BLOCK(2, H32, HB)

    PH_BEGIN {
        pg8::EpiStore eq = epi_plain((bf16_t*)(ws + WS_Q), 2048, 0.08838834764831845f * LOG2E); eq.O2 = (bf16_t*)(ws + WS_K); eq.split_col = 2048; eq.ldc2 = 2048; eq.scale2 = 1.f;
        run_gemm(lds, HB, (const bf16_t*)(ws + WS_W_MBIN), T, 4096, D, eq, G);
        run_gemm(lds, (const bf16_t*)(ws + WS_W_MBIN) + (size_t)4096 * D, HB, 2048, T, D, epi_plain(VT, T), G);
    } PH_END
    PH_BEGIN phase_kmean((const bf16_t*)(ws + WS_K), (float*)(ws + WS_KMEAN), lds, vcu, G); PH_END
    PH_BEGIN { AttnArgs a{(const bf16_t*)(ws + WS_Q), 2048, (const bf16_t*)(ws + WS_K), nullptr, VT, OB, (const float*)(ws + WS_KMEAN)}; phase_attn<2>(lds, a, vcu, G); } PH_END
    PH_BEGIN { pg8::EpiRes e{H32, H32, D, ALPHA}; run_gemm(lds, OB, (const bf16_t*)(ws + WS_W_MBO), T, D, D, e, G); } PH_END
    MLP_BLOCK(3, p.out, (bf16_t*)nullptr)
#undef PH_BEGIN
#undef PH_END
}

extern "C" void kernel_launch(void* const* d_in, const int* in_sizes, int n_in, void* d_out, int out_size, void* d_ws, size_t ws_size, hipStream_t stream) {
    static int grid = 0;
    if (grid == 0) {
        if (n_in != 19 || out_size != T * D || ws_size < WS_END) { fprintf(stderr, "kernel_launch: unexpected problem shape (n_in %d out %d ws %zu)\n", n_in, out_size, ws_size); grid = -1; return; }
        int dev = 0, cus = 0, per_cu = 0;
        (void)hipGetDevice(&dev); (void)hipDeviceGetAttribute(&cus, hipDeviceAttributeMultiprocessorCount, dev);
        if (hipFuncSetAttribute((const void*)fwd_megakernel, hipFuncAttributeMaxDynamicSharedMemorySize, LDS_BYTES) != hipSuccess) { fprintf(stderr, "kernel_launch: hipFuncSetAttribute failed\n"); grid = -1; return; }
        if (hipOccupancyMaxActiveBlocksPerMultiprocessor(&per_cu, (const void*)fwd_megakernel, 512, LDS_BYTES) != hipSuccess || per_cu < 1) { fprintf(stderr, "kernel_launch: occupancy query says %d\n", per_cu); per_cu = 1; }
        (void)hipGetLastError();
        grid = cus;
    }
    if (grid < 0) return;
    Params p{};
    for (int i = 0; i < 19; ++i) p.in[i] = (const float*)d_in[i];
    p.out = (float*)d_out; p.ws = (unsigned char*)d_ws; p.ph_lo = 0; p.ph_hi = 1 << 20;
    void* args[] = {&p};
    hipError_t e = hipLaunchCooperativeKernel((const void*)fwd_megakernel, dim3(grid), dim3(512), args, LDS_BYTES, stream);
    if (e != hipSuccess) fprintf(stderr, "kernel_launch: cooperative launch failed: %s (grid %d)\n", hipGetErrorString(e), grid);
}
```

```cpp
#include <hip/hip_runtime.h>
#include <hip/hip_cooperative_groups.h>
#include <cstdio>
#include <cstdint>
namespace cg = cooperative_groups;

namespace pg8 {
#define PG8_LAS __attribute__((address_space(3)))
typedef unsigned short bf16_t;
typedef short bf16x8 __attribute__((ext_vector_type(8)));
typedef float f32x4 __attribute__((ext_vector_type(4)));
typedef unsigned u32x4 __attribute__((ext_vector_type(4)));
constexpr int BM = 256, BK = 64, HALF = 128, HTB = HALF * BK * 2  , STAGE_BYTES = 8 * HTB, NXCD = 8, WGM = 8;

__host__ __device__ __forceinline__ int lds_byte(int r, int c) { const int st = (r >> 4) * 2 + (c >> 5), rr = r & 15, cc = c & 31, ob = rr * 64 + cc * 2; return st * 1024 + (ob ^ (((ob >> 9) & 1) << 5)); }
__host__ __device__ __forceinline__ void stage_rc(int b, int& R, int& C) { const int st = b / 1024, sb = b % 1024, swz = sb ^ (((sb >> 9) & 1) << 5); R = (st >> 1) * 16 + swz / 64; C = (st & 1) * 32 + (swz % 64) / 2; }
__host__ __device__ __forceinline__ int perm32(int rho) { const int n = rho >> 4, i = rho & 15; return 8 * (i >> 2) + 4 * n + (i & 3); }

struct Unit { int pm, pn; };
struct Gemm { const bf16_t* A; const bf16_t* Bt; int M, N, K; };

struct StaticOrder {
    int nM, nN, nwg, G, c;
    __host__ __device__ void init(int M, int N, int G_, int c_) { nM = M / BM; nN = N / BM; nwg = nM * nN; G = G_; c = c_; }
    __host__ __device__ bool next(int i, Unit& u) const {
        const long L = (long)i * G + c; if (L >= nwg) return false;
        int wgid = (int)L; { const int q = nwg / NXCD, r = nwg % NXCD, xcd = wgid % NXCD, off = wgid / NXCD; wgid = (xcd < r ? xcd * (q + 1) : r * (q + 1) + (xcd - r) * q) + off; }
        const int nig = WGM * nN, gid = wgid / nig, fm = gid * WGM, gsz = (nM - fm) < WGM ? (nM - fm) : WGM;
        u.pm = fm + ((wgid % nig) % gsz); u.pn = (wgid % nig) / gsz; return true;
    }
    __device__ __forceinline__ void a_ready(const Unit&) const {}
    __device__ __forceinline__ void done(const Unit&) const {}
};

typedef float f32x2 __attribute__((ext_vector_type(2)));
typedef __bf16 bf16x2_t __attribute__((ext_vector_type(2)));
__device__ __forceinline__ unsigned cvtpk(float lo, float hi) { f32x2 v = {lo, hi}; bf16x2_t b = __builtin_convertvector(v, bf16x2_t); return __builtin_bit_cast(unsigned, b); }

struct EpiStore {
    static constexpr bool PERM = true, AFTER_DRAIN = false;
    bf16_t* O; int ldc; float scale; int act;
    bf16_t* O2; int split_col; int ldc2; float scale2;
    const float* rope; int rope_col;
    __device__ __forceinline__ void operator()(const f32x4 (&acc)[2][2][4][2], const Unit& u, int wr, int wc, int fr, int fq) const {
        const int row0 = u.pm * BM + wr * 64 + fr; int colt = u.pn * BM; bf16_t* base = O; int ld = ldc; float sc = scale;
        const bool do_rope = (rope != nullptr) && (colt >= rope_col);
        if (colt >= split_col) { base = O2; ld = ldc2; sc = scale2; colt -= split_col; }
        const int col0 = colt + wc * 32 + 8 * fq;
#pragma unroll
        for (int ai = 0; ai < 2; ++ai)
#pragma unroll
            for (int m = 0; m < 4; ++m) { const int row = row0 + ai * HALF + m * 16; bf16_t* rowp = base + (size_t)row * ld + col0;
#pragma unroll
                for (int bj = 0; bj < 2; ++bj) { f32x4 v0 = acc[ai][bj][m][0], v1 = acc[ai][bj][m][1];
                    if (act == 1) {
#pragma unroll
                        for (int e = 0; e < 4; ++e) { float a = fmaxf(v0[e], 0.f), b = fmaxf(v1[e], 0.f); v0[e] = a * a; v1[e] = b * b; } }
                    if (do_rope) { const int gc = u.pn * BM + bj * HALF + wc * 32 + 8 * fq - rope_col; const int i0 = (gc & 63) >> 1; const int pos = row & 4095;
                        const f32x4 t0 = *(const f32x4*)(rope + ((size_t)pos * 32 + i0) * 2), t1 = *(const f32x4*)(rope + ((size_t)pos * 32 + i0 + 2) * 2);
                        f32x4 w0, w1;
                        w0[0] = v0[0] * t0[0] - v0[1] * t0[1]; w0[1] = v0[1] * t0[0] + v0[0] * t0[1];
                        w0[2] = v0[2] * t0[2] - v0[3] * t0[3]; w0[3] = v0[3] * t0[2] + v0[2] * t0[3];
                        w1[0] = v1[0] * t1[0] - v1[1] * t1[1]; w1[1] = v1[1] * t1[0] + v1[0] * t1[1];
                        w1[2] = v1[2] * t1[2] - v1[3] * t1[3]; w1[3] = v1[3] * t1[2] + v1[2] * t1[3];
                        v0 = w0; v1 = w1; }
                    v0 = v0 * sc; v1 = v1 * sc; u32x4 w; w.x = cvtpk(v0[0], v0[1]); w.y = cvtpk(v0[2], v0[3]); w.z = cvtpk(v1[0], v1[1]); w.w = cvtpk(v1[2], v1[3]);
                    *(u32x4*)(rowp + bj * HALF) = w; } }
    }
};
struct EpiRes {
    static constexpr bool PERM = false, AFTER_DRAIN = false;
    const float* hin; float* z; int ldc; float alpha;
    __device__ __forceinline__ void operator()(const f32x4 (&acc)[2][2][4][2], const Unit& u, int wr, int wc, int fr, int fq) const {
        const int row0 = u.pm * BM + wr * 64 + fr, col0 = u.pn * BM + wc * 32 + 4 * fq;
#pragma unroll
        for (int ai = 0; ai < 2; ++ai)
#pragma unroll
            for (int m = 0; m < 4; ++m) { const size_t off = (size_t)(row0 + ai * HALF + m * 16) * ldc + col0;
#pragma unroll
                for (int bj = 0; bj < 2; ++bj)
#pragma unroll
                    for (int n = 0; n < 2; ++n) { const f32x4 h4 = *(const f32x4*)(hin + off + bj * HALF + n * 16); *(f32x4*)(z + off + bj * HALF + n * 16) = h4 * alpha + acc[ai][bj][m][n]; } }
    }
};
template <class Epi, class Sched, bool ALIGN_EPI = false, bool SP2 = false>
__device__ __forceinline__ void gemm_phase(PG8_LAS unsigned char* lds, const Gemm g, const Sched& S, const Epi& E) {
    const int tid = threadIdx.x, wid = __builtin_amdgcn_readfirstlane(tid >> 6), lane = tid & 63, wr = wid >> 2, wc = wid & 3, fr = lane & 15, fq = lane >> 4;
    const int K = g.K, nt = K / BK;
    unsigned voffA[2], voffB[2];
#pragma unroll
    for (int i = 0; i < 2; ++i) { int R, C; stage_rc(tid * 16 + i * 8192, R, C); const int Rb = Epi::PERM ? ((R & ~31) + perm32(R & 31)) : R;
        voffA[i] = (unsigned)(R * K + C) * 2u; voffB[i] = (unsigned)(Rb * K + C) * 2u; }
    const size_t kstep = (size_t)(BK * 2);
    const size_t hstep = (size_t)HALF * K * 2;
    const size_t tstep = 2 * hstep;
    const unsigned ldsw = (unsigned)wid * 1024u;
    const int aoff = lds_byte(wr * 64 + fr, fq * 8), boff = lds_byte(wc * 32 + fr, fq * 8);
#define PG8_SA(b, h) (((b) * 2 + (h)) * HTB)
#define PG8_SB(b, h) ((4 + (b) * 2 + (h)) * HTB)
#define PG8_STAGE(bufoff, gbase, voff) do { _Pragma("unroll") for (int _i = 0; _i < 2; ++_i) \
        __builtin_amdgcn_global_load_lds((const unsigned*)((const char*)(gbase) + (voff)[_i]), (PG8_LAS unsigned*)(lds + (bufoff) + ldsw + _i * 8192), 16, 0, 0); } while (0)
#define PG8_LDA(dst, b, h) do { _Pragma("unroll") for (int m = 0; m < 4; ++m) _Pragma("unroll") for (int k = 0; k < 2; ++k) dst[m][k] = *(const PG8_LAS bf16x8*)(lds + PG8_SA(b, h) + aoff + m * 2048 + k * 1024); } while (0)
#define PG8_LDB(dst, b, h) do { _Pragma("unroll") for (int n = 0; n < 2; ++n) _Pragma("unroll") for (int k = 0; k < 2; ++k) dst[n][k] = *(const PG8_LAS bf16x8*)(lds + PG8_SB(b, h) + boff + n * 2048 + k * 1024); } while (0)
#define PG8_MMA(ai, bj, At, Bt) do { __builtin_amdgcn_s_setprio(1); _Pragma("unroll") for (int m = 0; m < 4; ++m) _Pragma("unroll") for (int n = 0; n < 2; ++n) _Pragma("unroll") for (int k = 0; k < 2; ++k) \
        acc[ai][bj][m][n] = __builtin_amdgcn_mfma_f32_16x16x32_bf16(Bt[n][k], At[m][k], acc[ai][bj][m][n], 0, 0, 0); __builtin_amdgcn_s_setprio(0); } while (0)
#define PG8_WAIT_V(n) asm volatile("s_waitcnt vmcnt(" #n ")" ::: "memory")
#define PG8_WAIT_L(n) asm volatile("s_waitcnt lgkmcnt(" #n ")" ::: "memory")
#define PG8_BAR __builtin_amdgcn_s_barrier()
#define PG8_SCHED __builtin_amdgcn_sched_barrier(0)
    Unit cur, nxt; int ui = 0;
    if (!S.next(0, cur)) return;
    f32x4 acc[2][2][4][2];
#pragma unroll
    for (int a = 0; a < 2; ++a)
#pragma unroll
        for (int b = 0; b < 2; ++b)
#pragma unroll
            for (int m = 0; m < 4; ++m)
#pragma unroll
                for (int n = 0; n < 2; ++n) acc[a][b][m][n] = (f32x4){0.f, 0.f, 0.f, 0.f};
    bf16x8 At[4][2], B0[2][2], B1[2][2];
    const char* cA = (const char*)g.A + (size_t)cur.pm * tstep; const char* cB = (const char*)g.Bt + (size_t)cur.pn * tstep;
    S.a_ready(cur);
    if constexpr (SP2) {
        PG8_STAGE(PG8_SB(0, 0), cB, voffB); PG8_STAGE(PG8_SB(0, 1), cB + hstep, voffB); PG8_STAGE(PG8_SA(0, 0), cA, voffA); PG8_STAGE(PG8_SA(0, 1), cA + hstep, voffA);
        if (wr == 1) PG8_BAR;
        PG8_WAIT_V(2); PG8_BAR;
        PG8_STAGE(PG8_SB(1, 0), cB + kstep, voffB); PG8_STAGE(PG8_SA(1, 0), cA + kstep, voffA); PG8_STAGE(PG8_SB(1, 1), cB + hstep + kstep, voffB);
        PG8_WAIT_V(6); PG8_BAR;
    } else {
        PG8_STAGE(PG8_SB(0, 0), cB, voffB); PG8_STAGE(PG8_SA(0, 0), cA, voffA); PG8_STAGE(PG8_SB(0, 1), cB + hstep, voffB); PG8_STAGE(PG8_SA(0, 1), cA + hstep, voffA);
        if (wr == 1) PG8_BAR;
        PG8_WAIT_V(4); PG8_BAR;
        PG8_STAGE(PG8_SB(1, 0), cB + kstep, voffB); PG8_STAGE(PG8_SA(1, 0), cA + kstep, voffA); PG8_STAGE(PG8_SB(1, 1), cB + hstep + kstep, voffB);
        PG8_WAIT_V(6); PG8_BAR;
    }
    for (;;) {
        const bool has_next = S.next(ui + 1, nxt);
        const char* nA = has_next ? (const char*)g.A + (size_t)nxt.pm * tstep : cA; const char* nB = has_next ? (const char*)g.Bt + (size_t)nxt.pn * tstep : cB;
        for (int t = 0; t < nt; t += 2) {
            const bool last = (t == nt - 2);
            const char* a1 = cA + (size_t)(t + 1) * kstep;
            const char* a2 = last ? nA : cA + (size_t)(t + 2) * kstep; const char* b2 = last ? nB : cB + (size_t)(t + 2) * kstep;
            const char* a3 = a2 + kstep; const char* b3 = b2 + kstep;
            if (last && has_next) S.a_ready(nxt);
            if constexpr (SP2) {
            PG8_LDB(B0, 0, 0); PG8_LDB(B1, 0, 1); PG8_SCHED; PG8_LDA(At, 0, 0); PG8_STAGE(PG8_SA(1, 1), a1 + hstep, voffA);
            PG8_WAIT_V(8); PG8_WAIT_L(0); PG8_BAR; PG8_MMA(0, 0, At, B0); PG8_MMA(0, 1, At, B1); PG8_BAR; PG8_SCHED;
            PG8_LDA(At, 0, 1); PG8_STAGE(PG8_SB(0, 0), b2, voffB); PG8_STAGE(PG8_SB(0, 1), b2 + hstep, voffB); PG8_STAGE(PG8_SA(0, 0), a2, voffA);
            PG8_WAIT_V(8); PG8_WAIT_L(0); PG8_BAR; PG8_MMA(1, 0, At, B0); PG8_MMA(1, 1, At, B1); PG8_BAR; PG8_SCHED;
            PG8_LDB(B0, 1, 0); PG8_LDB(B1, 1, 1); PG8_SCHED; PG8_LDA(At, 1, 0); PG8_STAGE(PG8_SA(0, 1), a2 + hstep, voffA);
            PG8_WAIT_V(8); PG8_WAIT_L(0); PG8_BAR; PG8_MMA(0, 0, At, B0); PG8_MMA(0, 1, At, B1); PG8_BAR; PG8_SCHED;
            PG8_LDA(At, 1, 1); PG8_STAGE(PG8_SB(1, 0), b3, voffB); PG8_STAGE(PG8_SB(1, 1), b3 + hstep, voffB); PG8_STAGE(PG8_SA(1, 0), a3, voffA);
            PG8_WAIT_V(8); PG8_WAIT_L(0); PG8_BAR; PG8_MMA(1, 0, At, B0); PG8_MMA(1, 1, At, B1); PG8_BAR; PG8_SCHED;
            } else {
            PG8_LDB(B0, 0, 0); PG8_SCHED; PG8_LDA(At, 0, 0); PG8_STAGE(PG8_SA(1, 1), a1 + hstep, voffA);
            PG8_WAIT_L(8); PG8_BAR; PG8_WAIT_L(0); PG8_MMA(0, 0, At, B0); PG8_BAR; PG8_SCHED;
            PG8_LDB(B1, 0, 1); PG8_STAGE(PG8_SB(0, 0), b2, voffB);
            PG8_BAR; PG8_WAIT_L(0); PG8_MMA(0, 1, At, B1); PG8_BAR;
            PG8_LDA(At, 0, 1); PG8_STAGE(PG8_SA(0, 0), a2, voffA);
            PG8_BAR; PG8_WAIT_L(0); PG8_MMA(1, 0, At, B0); PG8_BAR; PG8_SCHED;
            PG8_STAGE(PG8_SB(0, 1), b2 + hstep, voffB);
            PG8_WAIT_V(6); PG8_BAR; PG8_MMA(1, 1, At, B1); PG8_BAR;
            PG8_LDB(B0, 1, 0); PG8_SCHED; PG8_LDA(At, 1, 0); PG8_STAGE(PG8_SA(0, 1), a2 + hstep, voffA);
            PG8_WAIT_L(8); PG8_BAR; PG8_WAIT_L(0); PG8_MMA(0, 0, At, B0); PG8_BAR; PG8_SCHED;
            PG8_LDB(B1, 1, 1); PG8_STAGE(PG8_SB(1, 0), b3, voffB);
            PG8_BAR; PG8_WAIT_L(0); PG8_MMA(0, 1, At, B1); PG8_BAR;
            PG8_LDA(At, 1, 1); PG8_STAGE(PG8_SA(1, 0), a3, voffA);
            PG8_BAR; PG8_WAIT_L(0); PG8_MMA(1, 0, At, B0); PG8_BAR; PG8_SCHED;
            PG8_STAGE(PG8_SB(1, 1), b3 + hstep, voffB);
            PG8_WAIT_V(6); PG8_BAR; PG8_MMA(1, 1, At, B1); PG8_BAR;
            }
        }
        if constexpr (ALIGN_EPI) { if (wr == 0) PG8_BAR; }
        if constexpr (!Epi::AFTER_DRAIN) { E(acc, cur, wr, wc, fr, fq); S.done(cur); }
        if (!has_next) break;
#pragma unroll
        for (int a = 0; a < 2; ++a)
#pragma unroll
            for (int b = 0; b < 2; ++b)
#pragma unroll
                for (int m = 0; m < 4; ++m)
#pragma unroll
                    for (int n = 0; n < 2; ++n) acc[a][b][m][n] = (f32x4){0.f, 0.f, 0.f, 0.f};
        cur = nxt; cA = nA; cB = nB; ++ui;
        if constexpr (ALIGN_EPI) { if (wr == 1) PG8_BAR; }
    }
    PG8_WAIT_V(0);
    if constexpr (!ALIGN_EPI) { if (wr == 0) PG8_BAR; }
    PG8_BAR;
    if constexpr (Epi::AFTER_DRAIN) { E.fused(acc, cur, wr, wc, fr, fq, lds, wid, lane); S.done(cur); }
#undef PG8_SA
#undef PG8_SB
#undef PG8_STAGE
#undef PG8_LDA
#undef PG8_LDB
#undef PG8_MMA
#undef PG8_WAIT_V
#undef PG8_WAIT_L
#undef PG8_BAR
#undef PG8_SCHED
}
}

#define LAS __attribute__((address_space(3)))
typedef unsigned short bf16_t;
typedef float f32x4 __attribute__((ext_vector_type(4)));
typedef float f32x16 __attribute__((ext_vector_type(16)));
typedef short bf16x8 __attribute__((ext_vector_type(8)));
typedef short s16x4 __attribute__((ext_vector_type(4)));
typedef unsigned u32x4 __attribute__((ext_vector_type(4)));
typedef unsigned u32x2 __attribute__((ext_vector_type(2)));
using pg8::cvtpk;
#define MFMA32(a, b, c) __builtin_amdgcn_mfma_f32_32x32x16_bf16((a), (b), (c), 0, 0, 0)

constexpr int T = 8192, SEQ = 4096, D = 2048, FF = 8192, NH = 16;
constexpr float ALPHA = 1.681792830507429f;
constexpr float LN_EPS = 1e-5f, RMS_EPS = 1e-6f;
constexpr float LOG2E = 1.4426950408889634f;

constexpr size_t MiB = 1u << 20;
constexpr size_t WS_ROPE = 1 * MiB, WS_LB = 2 * MiB, WS_KMEAN = 3 * MiB;
constexpr size_t WS_W_MLAIN = 4 * MiB, WS_W_UQ = 9 * MiB, WS_W_UK = 12 * MiB, WS_W_UV = 14 * MiB, WS_W_MLAO = 16 * MiB;
constexpr size_t WS_W_HGIN = 24 * MiB, WS_W_HGO = 56 * MiB, WS_W_SBIN = 64 * MiB, WS_W_SBO = 88 * MiB, WS_W_MBIN = 96 * MiB, WS_W_MBO = 120 * MiB;
constexpr size_t WS_W1 = 128 * MiB, WS_W2 = 256 * MiB;
constexpr size_t WS_H32 = 384 * MiB, WS_HB = 448 * MiB, WS_BIG = 480 * MiB, WS_MIX = 608 * MiB;
constexpr size_t WS_H0 = WS_MIX, WS_CQN = WS_MIX + 20 * MiB, WS_CKVN = WS_MIX + 28 * MiB, WS_KR = WS_MIX + 36 * MiB, WS_Q3 = WS_MIX + 40 * MiB, WS_KN = WS_MIX + 88 * MiB, WS_VT = WS_MIX + 120 * MiB, WS_O = WS_MIX + 152 * MiB;
constexpr size_t WS_Q = WS_MIX, WS_K = WS_MIX + 32 * MiB;
constexpr size_t WS_QT = WS_MIX, WS_OI = WS_MIX + 32 * MiB, WS_DELTA = WS_MIX + 96 * MiB, WS_DEC = WS_MIX + 160 * MiB, WS_GO = WS_MIX + 162 * MiB;
constexpr size_t WS_END = WS_MIX + 200 * MiB;
static_assert(WS_END <= 1024 * MiB, "workspace");

constexpr int LDS_BYTES = 155648;
constexpr int NWAVES = 8;

__device__ __forceinline__ float bflo(unsigned u) { return __uint_as_float(u << 16); }
__device__ __forceinline__ float bfhi(unsigned u) { return __uint_as_float(u & 0xffff0000u); }
__device__ __forceinline__ float bf2f(unsigned short b) { return __uint_as_float(((unsigned)b) << 16); }
__device__ __forceinline__ unsigned short f2bf(float f) { return (unsigned short)(cvtpk(f, 0.f) & 0xffffu); }
__device__ __forceinline__ float wave_sum(float v) {
#pragma unroll
    for (int o = 1; o < 64; o <<= 1) v += __shfl_xor(v, o);
    return v;
}
__device__ __forceinline__ float xhalf(float v) {
    auto rr = __builtin_amdgcn_permlane32_swap(__float_as_uint(v), __float_as_uint(v), false, false);
    return __uint_as_float((threadIdx.x & 32) ? rr[0] : rr[1]);
}
__device__ __forceinline__ int crow(int r, int hi) { return (r & 3) + 8 * (r >> 2) + 4 * hi; }

struct Params { const float* in[19]; float* out; unsigned char* ws; int ph_lo, ph_hi; };

__device__ __forceinline__ int srccol(int mode, int n) {
    if (mode == 0) return n;
    if (mode == 1) { if (n < 2048) return (n >> 7) * 192 + (n & 127); const int r = n - 2048, h = r >> 6, q = r & 63; return h * 192 + 128 + (q >> 1) + 32 * (q & 1); }
    if (mode == 2) return (n >> 7) * 256 + (n & 127);
    if (mode == 3) return (n >> 7) * 256 + 128 + (n & 127);
    if (n < 1024) return n;
    if (n < 1088) { const int r = n - 1024; return 1024 + (r >> 1) + 32 * (r & 1); }
    return -1;
}
__device__ __forceinline__ void tr_job(const float* W, int K, int Nsrc, int nlo, int nhi, bf16_t* WT, int mode, LAS float* scr, int gw, int NGW, int lane) {
    const int nblk = (nhi - nlo) / 32, nitems = (K / 64) * nblk;
    for (int it = gw; it < nitems; it += NGW) {
        const int kb = it / nblk, nb = it % nblk, k0 = 64 * kb, n0 = nlo + 32 * nb;
        const int sc = srccol(mode, n0 + (lane & 31));
#pragma unroll 8
        for (int i = 0; i < 32; ++i) { const int kk = 2 * i + (lane >> 5); scr[kk * 33 + (lane & 31)] = sc >= 0 ? W[(size_t)(k0 + kk) * Nsrc + sc] : 0.f; }
        asm volatile("s_waitcnt lgkmcnt(0)" ::: "memory");
        const int c = lane & 7;
#pragma unroll
        for (int j = 0; j < 4; ++j) { const int n = (lane >> 3) + 8 * j; const LAS float* s = scr + (8 * c) * 33 + n;
            u32x4 o; o.x = cvtpk(s[0 * 33], s[1 * 33]); o.y = cvtpk(s[2 * 33], s[3 * 33]); o.z = cvtpk(s[4 * 33], s[5 * 33]); o.w = cvtpk(s[6 * 33], s[7 * 33]);
            *(u32x4*)(WT + (size_t)(n0 + n) * K + k0 + 8 * c) = o; }
        asm volatile("s_waitcnt lgkmcnt(0)" ::: "memory");
    }
}

__device__ __forceinline__ void tr_fast(const float* W, int K, int Nsrc, bf16_t* WT, int mode, int nlo, int nhi, int gw, int NGW, int lane) {
    const int kg = lane >> 4, ng = lane & 15; const int nblk = (nhi - nlo) / 64, kblk = K / 128, nitems = nblk * kblk;
    for (int it = gw; it < nitems; it += NGW) {
        const int nb = it / kblk, kb = it - nb * kblk; const int n = nlo + nb * 64 + 4 * ng; const int sc = srccol(mode, n);
        const float* src = W + (size_t)(kb * 128 + 8 * kg) * Nsrc + sc; bf16_t* dst = WT + (size_t)n * K + kb * 128 + 8 * kg;
#pragma unroll
        for (int sub = 0; sub < 4; ++sub) { f32x4 v[8];
#pragma unroll
            for (int e = 0; e < 8; ++e) v[e] = __builtin_nontemporal_load((const f32x4*)(src + (size_t)(sub * 32 + e) * Nsrc));
#pragma unroll
            for (int i = 0; i < 4; ++i) { u32x4 o; o.x = cvtpk(v[0][i], v[1][i]); o.y = cvtpk(v[2][i], v[3][i]); o.z = cvtpk(v[4][i], v[5][i]); o.w = cvtpk(v[6][i], v[7][i]);
                *(u32x4*)(dst + (size_t)i * K + sub * 32) = o; } }
    }
}
__device__ __forceinline__ void phase_prologue(const Params& p, LAS unsigned char* lds, int vcu, int G) {
    const int tid = threadIdx.x, lane = tid & 63, wave = tid >> 6;
    const int gw = vcu * NWAVES + wave, NGW = G * NWAVES;
    LAS float* scr = (LAS float*)(lds + wave * 8704);
    unsigned char* ws = p.ws;
    tr_fast(p.in[1], 2048, 1088, (bf16_t*)(ws + WS_W_MLAIN), 4, 0, 1024, gw, NGW, lane);
    tr_job(p.in[1], 2048, 1088, 1024, 1280, (bf16_t*)(ws + WS_W_MLAIN), 4, scr, gw, NGW, lane);
    tr_fast(p.in[4], 512, 3072, (bf16_t*)(ws + WS_W_UQ), 1, 0, 2048, gw, NGW, lane);
    tr_job(p.in[4], 512, 3072, 2048, 3072, (bf16_t*)(ws + WS_W_UQ), 1, scr, gw, NGW, lane);
    tr_fast(p.in[5], 512, 4096, (bf16_t*)(ws + WS_W_UK), 2, 0, 2048, gw, NGW, lane);
    tr_fast(p.in[5], 512, 4096, (bf16_t*)(ws + WS_W_UV), 3, 0, 2048, gw, NGW, lane);
    tr_fast(p.in[6], 2048, 2048, (bf16_t*)(ws + WS_W_MLAO), 0, 0, 2048, gw, NGW, lane);
    tr_fast(p.in[7], 2048, 8192, (bf16_t*)(ws + WS_W_HGIN), 0, 0, 8192, gw, NGW, lane);
    tr_fast(p.in[10], 2048, 2048, (bf16_t*)(ws + WS_W_HGO), 0, 0, 2048, gw, NGW, lane);
    tr_fast(p.in[11], 2048, 6144, (bf16_t*)(ws + WS_W_SBIN), 0, 0, 6144, gw, NGW, lane);
    tr_fast(p.in[12], 2048, 2048, (bf16_t*)(ws + WS_W_SBO), 0, 0, 2048, gw, NGW, lane);
    tr_fast(p.in[13], 2048, 6144, (bf16_t*)(ws + WS_W_MBIN), 0, 0, 6144, gw, NGW, lane);
    tr_fast(p.in[14], 2048, 2048, (bf16_t*)(ws + WS_W_MBO), 0, 0, 2048, gw, NGW, lane);
    for (int l = 0; l < 4; ++l) {
        tr_fast(p.in[17] + (size_t)l * D * FF, D, FF, (bf16_t*)(ws + WS_W1) + (size_t)l * D * FF, 0, 0, FF, gw, NGW, lane);
        tr_fast(p.in[18] + (size_t)l * D * FF, FF, D, (bf16_t*)(ws + WS_W2) + (size_t)l * D * FF, 0, 0, D, gw, NGW, lane);
    }
    { const f32x4* x4 = (const f32x4*)p.in[0]; u32x2* hb = (u32x2*)(ws + WS_HB); const int gt = vcu * 512 + tid, NT = G * 512;
      for (int i = gt; i < T * D / 4; i += NT) { const f32x4 v = x4[i]; u32x2 o; o.x = cvtpk(v[0], v[1]); o.y = cvtpk(v[2], v[3]); hb[i] = o; } }
    { float* rt = (float*)(ws + WS_ROPE); const int gt = vcu * 512 + tid, NT = G * 512;
      for (int e = gt; e < SEQ * 32; e += NT) { const int pos = e >> 5, i = e & 31;
          const float inv = 1.0f / exp2f((float)i * (13.287712379549449f / 32.0f));
          const float ang = (float)pos * inv;
          const double rev = (double)ang * 0.15915494309189535; const float fr = (float)(rev - floor(rev));
          rt[2 * e] = __builtin_amdgcn_cosf(fr); rt[2 * e + 1] = __builtin_amdgcn_sinf(fr); } }
    { float* lb = (float*)(ws + WS_LB); const float* lg = p.in[8]; const int gt = vcu * 512 + tid;
      if (gt < D) { const float a0 = lg[gt], a1 = lg[D + gt], a2 = lg[2 * D + gt], a3 = lg[3 * D + gt]; const float mx = fmaxf(fmaxf(a0, a1), fmaxf(a2, a3));
          const float e0 = expf(a0 - mx), e1 = expf(a1 - mx), e2 = expf(a2 - mx), e3 = expf(a3 - mx); lb[gt] = e1 / (e0 + e1 + e2 + e3); } }
}

__device__ __forceinline__ void phase_ln(const float* Z, const float* g, const float* bt, float* H, bf16_t* HB, int vcu, int G) {
    const int tid = threadIdx.x, lane = tid & 63, wave = tid >> 6; const int gw = vcu * NWAVES + wave, NGW = G * NWAVES;
    for (int m = gw; m < T; m += NGW) {
        const f32x4* zr = (const f32x4*)(Z + (size_t)m * D) + lane; f32x4 v[8]; float s = 0.f;
#pragma unroll
        for (int j = 0; j < 8; ++j) { v[j] = zr[64 * j]; s += (v[j][0] + v[j][1]) + (v[j][2] + v[j][3]); }
        const float mean = wave_sum(s) * (1.f / D); float s2 = 0.f;
#pragma unroll
        for (int j = 0; j < 8; ++j) { v[j] = v[j] - mean; s2 += (v[j][0] * v[j][0] + v[j][1] * v[j][1]) + (v[j][2] * v[j][2] + v[j][3] * v[j][3]); }
        const float rstd = 1.f / sqrtf(wave_sum(s2) * (1.f / D) + LN_EPS);
        f32x4* hr = (f32x4*)(H + (size_t)m * D) + lane; u32x2* br = HB ? (u32x2*)(HB + (size_t)m * D) + lane : nullptr;
#pragma unroll
        for (int j = 0; j < 8; ++j) { const f32x4 gg = ((const f32x4*)g)[lane + 64 * j], bb = ((const f32x4*)bt)[lane + 64 * j]; const f32x4 y = v[j] * rstd * gg + bb;
            hr[64 * j] = y; if (br) { u32x2 o; o.x = cvtpk(y[0], y[1]); o.y = cvtpk(y[2], y[3]); br[64 * j] = o; } }
    }
}
__device__ __forceinline__ void phase_mla_prep(const bf16_t* H0, const float* qn, const float* kvn, const float* rope, bf16_t* CQN, bf16_t* CKVN, bf16_t* KR, int vcu, int G) {
    const int tid = threadIdx.x, lane = tid & 63, wave = tid >> 6; const int gw = vcu * NWAVES + wave, NGW = G * NWAVES;
    for (int m = gw; m < T; m += NGW) {
        const bf16_t* row = H0 + (size_t)m * 1280;
#pragma unroll
        for (int part = 0; part < 2; ++part) {
            const u32x4 raw = *(const u32x4*)(row + part * 512 + 8 * lane);
            float v[8]; v[0] = bflo(raw.x); v[1] = bfhi(raw.x); v[2] = bflo(raw.y); v[3] = bfhi(raw.y); v[4] = bflo(raw.z); v[5] = bfhi(raw.z); v[6] = bflo(raw.w); v[7] = bfhi(raw.w);
            float ss = 0.f;
#pragma unroll
            for (int j = 0; j < 8; ++j) ss += v[j] * v[j];
            const float r = 1.f / sqrtf(wave_sum(ss) * (1.f / 512.f) + RMS_EPS);
            const float* gp = (part ? kvn : qn) + 8 * lane; const f32x4 g0 = *(const f32x4*)gp, g1 = *(const f32x4*)(gp + 4);
            u32x4 o; o.x = cvtpk(v[0] * r * g0[0], v[1] * r * g0[1]); o.y = cvtpk(v[2] * r * g0[2], v[3] * r * g0[3]); o.z = cvtpk(v[4] * r * g1[0], v[5] * r * g1[1]); o.w = cvtpk(v[6] * r * g1[2], v[7] * r * g1[3]);
            *(u32x4*)((part ? CKVN : CQN) + (size_t)m * 512 + 8 * lane) = o;
        }
        if (lane < 32) { const unsigned raw = *(const unsigned*)(row + 1024 + 2 * lane); const float x1 = bflo(raw), x2 = bfhi(raw); const int pos = m & (SEQ - 1);
            const float c = rope[((size_t)pos * 32 + lane) * 2], s = rope[((size_t)pos * 32 + lane) * 2 + 1];
            *(unsigned*)(KR + (size_t)m * 64 + 2 * lane) = cvtpk(x1 * c - x2 * s, x2 * c + x1 * s); }
    }
}
__device__ __forceinline__ void phase_kmean(const bf16_t* K, float* KM, LAS unsigned char* lds, int vcu, int G) {
    const int tid = threadIdx.x; LAS float* red = (LAS float*)lds;
    for (int u = vcu; u < 512; u += G) { const int bh = u >> 4, blk = u & 15, b = bh >> 4, h = bh & 15;
        const int d = tid & 127, part = tid >> 7; float s = 0.f;
        const bf16_t* kp = K + (size_t)(b * SEQ + blk * 256 + part * 64) * D + h * 128 + d;
        for (int r = 0; r < 64; ++r) s += bf2f(kp[(size_t)r * D]);
        red[part * 128 + d] = s; __syncthreads();
        if (tid < 128) KM[(size_t)u * 128 + tid] = (red[tid] + red[128 + tid] + red[256 + tid] + red[384 + tid]) * (1.f / 256.f);
        __syncthreads(); }
}

struct AttnArgs { const bf16_t* Q; int ldq; const bf16_t* K; const bf16_t* Kr; const bf16_t* VT; bf16_t* O; const float* KM; };
constexpr float NEGBIG = -1.0e30f;

template <int MODE>
__device__ __forceinline__ void attn_unit(LAS unsigned char* lds, const AttnArgs& A, int b, int h, int qb) {
    constexpr int DK = MODE == 0 ? 192 : 128, ND = DK / 16, CPK = DK / 8, KP = DK * 2, KTB = 64 * KP, VP = 128, VTB = 128 * VP, BUF = KTB + VTB, NKC = (64 * CPK) / 512, MISC = 2 * BUF;
    const int tid = threadIdx.x, lane = tid & 63, wave = __builtin_amdgcn_readfirstlane(tid >> 6), r32 = lane & 31, hi = lane >> 5;
    const int q0 = qb * 256, qw0 = q0 + wave * 32, qi = qw0 + r32;
    const size_t tokq = (size_t)b * SEQ + qi;
    bf16x8 qf[ND];
#pragma unroll
    for (int d0 = 0; d0 < 8; ++d0) qf[d0] = *(const bf16x8*)(A.Q + tokq * A.ldq + h * 128 + 16 * d0 + 8 * hi);
    LAS unsigned char* qlds = lds + MISC + (MODE == 2 ? 8192 : 0) + wave * 8192 + lane * 16;
    if constexpr (MODE != 1) {
#pragma unroll
        for (int d0 = 0; d0 < 8; ++d0) *(LAS bf16x8*)(qlds + d0 * 1024) = qf[d0];
    }
    const bf16_t* qrp = A.Q + tokq * A.ldq + 2048 + h * 64 + 8 * hi;
    unsigned sel = 0u, umask = 0u; int nT = (q0 + 256) / 64;
    if constexpr (MODE == 2) {
        const int blk = qb;
        LAS unsigned* um = (LAS unsigned*)(lds + MISC); LAS float* km = (LAS float*)(lds + MISC + 64);
        for (int i = tid; i < blk * 128; i += 512) km[i] = A.KM[(size_t)((b * 16 + h) * 16) * 128 + i];
        if (tid == 0) um[0] = 0u;
        __syncthreads();
        float v0 = -INFINITY, v1 = -INFINITY, v2 = -INFINITY; int i0 = -1, i1 = -1, i2 = -1;
        for (int j = 0; j < blk; ++j) {
            float g = 0.f;
#pragma unroll
            for (int d0 = 0; d0 < 8; ++d0)
#pragma unroll
                for (int jj = 0; jj < 8; ++jj) g += bf2f((unsigned short)qf[d0][jj]) * km[j * 128 + 16 * d0 + 8 * hi + jj];
            g += xhalf(g);
            if (g > v0) { v2 = v1; i2 = i1; v1 = v0; i1 = i0; v0 = g; i0 = j; }
            else if (g > v1) { v2 = v1; i2 = i1; v1 = g; i1 = j; }
            else if (g > v2) { v2 = g; i2 = j; }
        }
        if (i0 >= 0) sel |= 1u << i0; if (i1 >= 0) sel |= 1u << i1; if (i2 >= 0) sel |= 1u << i2;
        if (sel) atomicOr((unsigned*)um, sel);
        __syncthreads();
        umask = um[0];
        nT = 4 + 4 * __builtin_popcount(umask);
    }
    auto tile_base = [&](int n) -> int {
        if constexpr (MODE == 0) return 64 * n;
        else if constexpr (MODE == 1) return 64 * (nT - 1 - n);
        else { if (n < 4) return q0 + 64 * n; unsigned m = umask; const int k = (n - 4) >> 2; for (int i = 0; i < k; ++i) m &= m - 1; return 256 * __builtin_ctz(m) + 64 * ((n - 4) & 3); }
    };
#define ATT_DMA(kbase_, bufoff_) do { const int kb_ = (kbase_); const int bo_ = (bufoff_); \
        _Pragma("unroll") for (int i_ = 0; i_ < NKC; ++i_) { const int piece_ = wave + 8 * i_; const int P_ = piece_ * 64 + lane, key_ = P_ / CPK, cpp_ = P_ - key_ * CPK; \
            const int cp_ = cpp_ ^ (DK == 128 ? (key_ & 15) : ((key_ >> 1) & 7)); const size_t tok_ = (size_t)b * SEQ + kb_ + key_; \
            const bf16_t* src_ = (MODE == 0 && cp_ >= 16) ? A.Kr + tok_ * 64 + (cp_ - 16) * 8 : A.K + tok_ * 2048 + h * 128 + cp_ * 8; \
            __builtin_amdgcn_global_load_lds((const unsigned*)src_, (LAS unsigned*)(lds + bo_ + piece_ * 1024), 16, 0, 0); } \
        _Pragma("unroll") for (int i_ = 0; i_ < 2; ++i_) { const int piece_ = wave + 8 * i_; const int P_ = piece_ * 64 + lane, d_ = P_ >> 3, cp_ = (P_ & 7) ^ (d_ & 7); \
            const bf16_t* src_ = A.VT + (size_t)(h * 128 + d_) * T + (size_t)b * SEQ + kb_ + cp_ * 8; \
            __builtin_amdgcn_global_load_lds((const unsigned*)src_, (LAS unsigned*)(lds + bo_ + KTB + piece_ * 1024), 16, 0, 0); } } while (0)
#define ATT_WAIT() do { asm volatile("s_waitcnt vmcnt(0)" ::: "memory"); __syncthreads(); } while (0)

    f32x16 o[4];
#pragma unroll
    for (int i = 0; i < 4; ++i)
#pragma unroll
        for (int r = 0; r < 16; ++r) o[i][r] = 0.f;
    float mrun = NEGBIG, lrun = 0.f, carry = 0.f;

    ATT_DMA(tile_base(0), 0); ATT_WAIT();
    for (int n = 0; n < nT; ++n) {
        const int kbase = tile_base(n), bufoff = (n & 1) * BUF;
        if (n + 1 < nT) ATT_DMA(tile_base(n + 1), ((n + 1) & 1) * BUF);
        bool active, causal = false, off = false;
        if constexpr (MODE == 0) { active = kbase <= qw0 + 31; causal = kbase + 63 > qw0; }
        else if constexpr (MODE == 1) { active = kbase <= qw0 + 31; }
        else { if (n < 4) { active = kbase <= qw0 + 31; causal = kbase + 63 > qw0; }
               else { const int jb = kbase >> 8; off = ((sel >> jb) & 1u) == 0u; active = __ballot(!off) != 0ull; } }
        if (active) {
            f32x16 s0, s1;
#pragma unroll
            for (int r = 0; r < 16; ++r) { s0[r] = 0.f; s1[r] = 0.f; }
            const LAS unsigned char* kb = lds + bufoff + r32 * KP; const int fxk = DK == 128 ? (r32 & 15) : ((r32 >> 1) & 7);
            bf16x8 qr[4];
            if constexpr (MODE == 0) { const bf16_t* qq = qrp; asm volatile("" : "+v"(qq));
#pragma unroll
                for (int e = 0; e < 4; ++e) qr[e] = *(const bf16x8*)(qq + 16 * e); }
#pragma unroll
            for (int d0 = 0; d0 < ND; ++d0) { const int ko = ((2 * d0 + hi) ^ fxk) << 4; const bf16x8 k0 = *(const LAS bf16x8*)(kb + ko), k1 = *(const LAS bf16x8*)(kb + 32 * KP + ko);
                bf16x8 qv;
                if constexpr (MODE != 1) { if (d0 < 8) qv = *(const LAS bf16x8*)(qlds + d0 * 1024); else qv = qr[d0 & 3]; } else qv = qf[d0];
                s0 = MFMA32(k0, qv, s0); s1 = MFMA32(k1, qv, s1); }
            bf16x8 pb[4];
            if constexpr (MODE == 1) {
                float X[32], LZ[32];
#pragma unroll
                for (int i = 0; i < 32; ++i) { const float z = i < 16 ? s0[i & 15] : s1[i & 15]; const int key = kbase + 8 * (i >> 2) + 4 * hi + (i & 3); const bool strict = key < qi;
                    const float u = __builtin_amdgcn_exp2f(-fabsf(z)); const float sp = fmaxf(z, 0.f) + __builtin_amdgcn_logf(1.f + u);
                    X[i] = strict ? -sp : 0.f; LZ[i] = strict ? (z - sp) : NEGBIG; }
                float gs[8], og[8];
#pragma unroll
                for (int g = 0; g < 8; ++g) { gs[g] = (X[4 * g] + X[4 * g + 1]) + (X[4 * g + 2] + X[4 * g + 3]); og[g] = xhalf(gs[g]); }
                float run = carry;
#pragma unroll
                for (int g = 7; g >= 0; --g) { const float a3 = run + (hi ? 0.f : og[g]); const float a2 = a3 + X[4 * g + 3], a1 = a2 + X[4 * g + 2], a0 = a1 + X[4 * g + 1];
                    LZ[4 * g + 3] = __builtin_amdgcn_exp2f(LZ[4 * g + 3] + a3); LZ[4 * g + 2] = __builtin_amdgcn_exp2f(LZ[4 * g + 2] + a2);
                    LZ[4 * g + 1] = __builtin_amdgcn_exp2f(LZ[4 * g + 1] + a1); LZ[4 * g] = __builtin_amdgcn_exp2f(LZ[4 * g] + a0);
                    run += gs[g] + og[g]; }
                carry = run;
#pragma unroll
                for (int c = 0; c < 4; ++c) { u32x4 w; w.x = cvtpk(LZ[8 * c], LZ[8 * c + 1]); w.y = cvtpk(LZ[8 * c + 2], LZ[8 * c + 3]); w.z = cvtpk(LZ[8 * c + 4], LZ[8 * c + 5]); w.w = cvtpk(LZ[8 * c + 6], LZ[8 * c + 7]); pb[c] = __builtin_bit_cast(bf16x8, w); }
            } else {
                if (causal) {
#pragma unroll
                    for (int r = 0; r < 16; ++r) { const int key = kbase + crow(r, hi); if (key > qi) s0[r] = NEGBIG; if (key + 32 > qi) s1[r] = NEGBIG; }
                }
                if (MODE == 2 && off) {
#pragma unroll
                    for (int r = 0; r < 16; ++r) { s0[r] = NEGBIG; s1[r] = NEGBIG; }
                }
                float mx = fmaxf(s0[0], s1[0]);
#pragma unroll
                for (int r = 1; r < 16; ++r) mx = fmaxf(mx, fmaxf(s0[r], s1[r]));
                mx = fmaxf(mx, xhalf(mx));
                const float mnew = fmaxf(mrun, mx), alpha = __builtin_amdgcn_exp2f(mrun - mnew); mrun = mnew;
                float ls = 0.f;
#pragma unroll
                for (int r = 0; r < 16; ++r) { s0[r] = __builtin_amdgcn_exp2f(s0[r] - mnew); s1[r] = __builtin_amdgcn_exp2f(s1[r] - mnew); ls += s0[r] + s1[r]; }
                lrun = lrun * alpha + ls;
#pragma unroll
                for (int i = 0; i < 4; ++i)
#pragma unroll
                    for (int r = 0; r < 16; ++r) o[i][r] *= alpha;
#pragma unroll
                for (int c = 0; c < 4; ++c) { u32x4 w;
                    if (c < 2) { w.x = cvtpk(s0[8 * c], s0[8 * c + 1]); w.y = cvtpk(s0[8 * c + 2], s0[8 * c + 3]); w.z = cvtpk(s0[8 * c + 4], s0[8 * c + 5]); w.w = cvtpk(s0[8 * c + 6], s0[8 * c + 7]); }
                    else { const int cc = c - 2; w.x = cvtpk(s1[8 * cc], s1[8 * cc + 1]); w.y = cvtpk(s1[8 * cc + 2], s1[8 * cc + 3]); w.z = cvtpk(s1[8 * cc + 4], s1[8 * cc + 5]); w.w = cvtpk(s1[8 * cc + 6], s1[8 * cc + 7]); }
                    pb[c] = __builtin_bit_cast(bf16x8, w); }
            }
            const LAS unsigned char* vb = lds + bufoff + KTB + r32 * VP + hi * 8; const int fxv = r32 & 7;
#pragma unroll
            for (int db = 0; db < 4; ++db)
#pragma unroll
                for (int c = 0; c < 4; ++c) { const s16x4 lo = *(const LAS s16x4*)(vb + db * 32 * VP + (((2 * c) ^ fxv) << 4)), h4 = *(const LAS s16x4*)(vb + db * 32 * VP + (((2 * c + 1) ^ fxv) << 4));
                    const bf16x8 vf = {lo[0], lo[1], lo[2], lo[3], h4[0], h4[1], h4[2], h4[3]};
                    o[db] = MFMA32(vf, pb[c], o[db]); }
        }
        if constexpr (MODE == 1) {
            volatile LAS unsigned* slot = (volatile LAS unsigned*)(lds + MISC) + (n & 1) * 8;
            const bool wdone = __all(carry < -152.f);
            if (lane == 0) slot[wave] = wdone ? 1u : 0u;
            ATT_WAIT();
            const unsigned alld = slot[0] & slot[1] & slot[2] & slot[3] & slot[4] & slot[5] & slot[6] & slot[7];
            if (alld) break;
        } else ATT_WAIT();
    }
#undef ATT_DMA
#undef ATT_WAIT
    float inv = 1.f;
    if constexpr (MODE != 1) { const float lt = lrun + xhalf(lrun); inv = 1.f / lt; }
    bf16_t* orow = A.O + tokq * D + h * 128 + 4 * hi;
#pragma unroll
    for (int db = 0; db < 4; ++db)
#pragma unroll
        for (int g = 0; g < 4; ++g) { u32x2 w; w.x = cvtpk(o[db][4 * g] * inv, o[db][4 * g + 1] * inv); w.y = cvtpk(o[db][4 * g + 2] * inv, o[db][4 * g + 3] * inv);
            *(u32x2*)(orow + 32 * db + 8 * g) = w; }
}

template <int MODE>
__device__ __forceinline__ void phase_attn(LAS unsigned char* lds, const AttnArgs& A, int vcu, int G) {
    if constexpr (MODE == 2) { for (int u = vcu; u < 512; u += G) { const int blk = 15 - (u >> 5), bh = u & 31; attn_unit<2>(lds, A, bh >> 4, bh & 15, blk); } }
    else { for (int it = vcu; it < 256; it += G) { const int bh = it >> 3, s = it & 7; attn_unit<MODE>(lds, A, bh >> 4, bh & 15, 15 - s); attn_unit<MODE>(lds, A, bh >> 4, bh & 15, s); } }
}

__device__ __forceinline__ void hgrn_h1_unit(LAS unsigned char* lds, const bf16_t* BIG, const float* lb, bf16_t* QT, float* OI, bf16_t* DELTA, float* DEC, int unit) {
    constexpr int QA = 0, KA0 = 17408, KA1 = 26112, KHT = 43520, VTL = 60928, SEGO = 78336, RP = 272, VP = 136;
    const int tid = threadIdx.x, lane = tid & 63, wave = __builtin_amdgcn_readfirstlane(tid >> 6), r32 = lane & 31, hi = lane >> 5;
    const int bh = unit >> 6, c = unit & 63, b = bh >> 4, h = bh & 15;
    const int d = tid & 127, part = tid >> 7;
    const size_t tok0 = (size_t)b * SEQ + c * 64 + part * 16;
    LAS float* SEG = (LAS float*)(lds + SEGO);
    const float lbd = lb[h * 128 + d], oml = 1.f - lbd;
    float qv[16], bb[16], kv[16]; float run = 0.f; unsigned vp[8];
#pragma unroll
    for (int i = 0; i < 16; ++i) { const bf16_t* row = BIG + (tok0 + i) * 8192 + h * 128 + d;
        const float q = bf2f(row[0]), fp = bf2f(row[2048]); const unsigned short vraw = row[4096];
        const float e = __expf(-fp); const float sig = 1.f / (1.f + e); const float f = lbd + oml * sig;
        const float lf = __logf(f); const float k = oml * (1.f - sig);
        run += lf; bb[i] = run; qv[i] = q; kv[i] = k;
        if (i & 1) vp[i >> 1] |= ((unsigned)vraw) << 16; else vp[i >> 1] = vraw; }
    SEG[part * 128 + d] = run;
    { LAS unsigned char* vt = lds + VTL + d * VP + part * 32;
#pragma unroll
      for (int j = 0; j < 4; ++j) *(LAS u32x2*)(vt + 8 * j) = (u32x2){vp[2 * j], vp[2 * j + 1]}; }
    __syncthreads();
    const float s0 = SEG[d], s1 = SEG[128 + d], s2 = SEG[256 + d], s3 = SEG[384 + d];
    const float prefix = part == 0 ? 0.f : part == 1 ? s0 : part == 2 ? s0 + s1 : (s0 + s1) + s2;
    const float bend = ((s0 + s1) + s2) + s3, beta1 = s0 + s1, betaI = part >= 2 ? beta1 : 0.f;
    unsigned khp[8];
#pragma unroll
    for (int i = 0; i < 16; ++i) { const float bt = prefix + bb[i]; const int t = part * 16 + i;
        *(LAS bf16_t*)(lds + QA + t * RP + 2 * d) = f2bf(qv[i] * __expf(bt - betaI));
        QT[(tok0 + i) * D + h * 128 + d] = f2bf(qv[i] * __expf(bt));
        if (part < 2) *(LAS bf16_t*)(lds + KA0 + t * RP + 2 * d) = f2bf(kv[i] * __expf(fminf(-bt, 80.f)));
        *(LAS bf16_t*)(lds + KA1 + t * RP + 2 * d) = f2bf(kv[i] * __expf(fminf(beta1 - bt, 80.f)));
        const unsigned short kh = f2bf(kv[i] * __expf(bend - bt));
        if (i & 1) khp[i >> 1] |= ((unsigned)kh) << 16; else khp[i >> 1] = kh; }
    { LAS unsigned char* kt = lds + KHT + d * VP + part * 32;
#pragma unroll
      for (int j = 0; j < 4; ++j) *(LAS u32x2*)(kt + 8 * j) = (u32x2){khp[2 * j], khp[2 * j + 1]}; }
    if (part == 0) DEC[(size_t)unit * 128 + d] = __expf(bend);
    __syncthreads();
    const int tg = wave & 1, dblk = wave >> 1;
    f32x16 sA0, sA1;
#pragma unroll
    for (int r = 0; r < 16; ++r) { sA0[r] = 0.f; sA1[r] = 0.f; }
    { const LAS unsigned char* qa = lds + QA + (32 * tg + r32) * RP + 16 * hi; const LAS unsigned char* ka = lds + (tg ? KA1 : KA0) + r32 * RP + 16 * hi;
#pragma unroll
      for (int d0 = 0; d0 < 8; ++d0) { const bf16x8 qfr = *(const LAS bf16x8*)(qa + 32 * d0); const bf16x8 k0 = *(const LAS bf16x8*)(ka + 32 * d0);
          sA0 = MFMA32(k0, qfr, sA0);
          if (tg) { const bf16x8 k1 = *(const LAS bf16x8*)(ka + 32 * RP + 32 * d0); sA1 = MFMA32(k1, qfr, sA1); } } }
    if (tg == 0) {
#pragma unroll
        for (int r = 0; r < 16; ++r) if (crow(r, hi) > r32) sA0[r] = 0.f;
    } else {
#pragma unroll
        for (int r = 0; r < 16; ++r) if (crow(r, hi) > r32) sA1[r] = 0.f;
    }
    bf16x8 pb[4];
#pragma unroll
    for (int cc = 0; cc < 2; ++cc) { u32x4 w; w.x = cvtpk(sA0[8 * cc], sA0[8 * cc + 1]); w.y = cvtpk(sA0[8 * cc + 2], sA0[8 * cc + 3]); w.z = cvtpk(sA0[8 * cc + 4], sA0[8 * cc + 5]); w.w = cvtpk(sA0[8 * cc + 6], sA0[8 * cc + 7]); pb[cc] = __builtin_bit_cast(bf16x8, w);
        u32x4 w2; w2.x = cvtpk(sA1[8 * cc], sA1[8 * cc + 1]); w2.y = cvtpk(sA1[8 * cc + 2], sA1[8 * cc + 3]); w2.z = cvtpk(sA1[8 * cc + 4], sA1[8 * cc + 5]); w2.w = cvtpk(sA1[8 * cc + 6], sA1[8 * cc + 7]); pb[2 + cc] = __builtin_bit_cast(bf16x8, w2); }
    bf16x8 vf[4];
    { const LAS unsigned char* vb = lds + VTL + (32 * dblk + r32) * VP + 8 * hi;
#pragma unroll
      for (int cc = 0; cc < 4; ++cc) { const s16x4 lo = *(const LAS s16x4*)(vb + 32 * cc), h4 = *(const LAS s16x4*)(vb + 32 * cc + 16); vf[cc] = (bf16x8){lo[0], lo[1], lo[2], lo[3], h4[0], h4[1], h4[2], h4[3]}; } }
    f32x16 oi;
#pragma unroll
    for (int r = 0; r < 16; ++r) oi[r] = 0.f;
    oi = MFMA32(vf[0], pb[0], oi); oi = MFMA32(vf[1], pb[1], oi);
    if (tg) { oi = MFMA32(vf[2], pb[2], oi); oi = MFMA32(vf[3], pb[3], oi); }
    { f32x4* op = (f32x4*)(OI + ((size_t)(unit * 8 + wave) * 64 + lane) * 16);
#pragma unroll
      for (int j = 0; j < 4; ++j) op[j] = (f32x4){oi[4 * j], oi[4 * j + 1], oi[4 * j + 2], oi[4 * j + 3]}; }
#pragma unroll
    for (int dbi = 0; dbi < 2; ++dbi) { const int db = 2 * tg + dbi; f32x16 dl;
#pragma unroll
        for (int r = 0; r < 16; ++r) dl[r] = 0.f;
        const LAS unsigned char* kb = lds + KHT + (32 * db + r32) * VP + 8 * hi;
#pragma unroll
        for (int cc = 0; cc < 4; ++cc) { const s16x4 lo = *(const LAS s16x4*)(kb + 32 * cc), h4 = *(const LAS s16x4*)(kb + 32 * cc + 16); const bf16x8 kf = {lo[0], lo[1], lo[2], lo[3], h4[0], h4[1], h4[2], h4[3]};
            dl = MFMA32(vf[cc], kf, dl); }
        bf16_t* dp = DELTA + ((size_t)unit * 128 + 32 * dblk) * 128 + 32 * db + r32;
#pragma unroll
        for (int r = 0; r < 16; ++r) dp[(size_t)crow(r, hi) * 128] = f2bf(dl[r]); }
    __syncthreads();
}
__device__ __forceinline__ void phase_hgrn_scan(bf16_t* DELTA, const float* DEC, int vcu, int G) {
    const int gt = vcu * 512 + threadIdx.x, NT = G * 512;
    for (int e = gt; e < 32 * 128 * 32; e += NT) { const int bh = e >> 12, v = (e >> 5) & 127, d4 = e & 31;
        float S0 = 0.f, S1 = 0.f, S2 = 0.f, S3 = 0.f;
#pragma unroll 8
        for (int c = 0; c < 64; ++c) { const size_t unit = (size_t)bh * 64 + c; u32x2* ptr = (u32x2*)(DELTA + (unit * 128 + v) * 128 + 4 * d4);
            const u32x2 raw = *ptr; const f32x4 dc = *(const f32x4*)(DEC + unit * 128 + 4 * d4);
            u32x2 w; w.x = cvtpk(S0, S1); w.y = cvtpk(S2, S3); *ptr = w;
            S0 = dc[0] * S0 + bflo(raw.x); S1 = dc[1] * S1 + bfhi(raw.x); S2 = dc[2] * S2 + bflo(raw.y); S3 = dc[3] * S3 + bfhi(raw.y); } }
}
__device__ __forceinline__ void hgrn_h3_unit(LAS unsigned char* lds, const bf16_t* BIG, const bf16_t* QT, const float* OI, const bf16_t* ST, const float* onorm, bf16_t* GO, int unit) {
    const int tid = threadIdx.x, lane = tid & 63, wave = __builtin_amdgcn_readfirstlane(tid >> 6), r32 = lane & 31, hi = lane >> 5;
    const int bh = unit >> 6, c = unit & 63, b = bh >> 4, h = bh & 15, tg = wave & 1, dblk = wave >> 1;
    const size_t tok = (size_t)b * SEQ + c * 64 + 32 * tg + r32;
    LAS float* red = (LAS float*)lds;
    f32x16 o;
    { const f32x4* op = (const f32x4*)(OI + ((size_t)(unit * 8 + wave) * 64 + lane) * 16);
#pragma unroll
      for (int j = 0; j < 4; ++j) { const f32x4 t4 = op[j]; o[4 * j] = t4[0]; o[4 * j + 1] = t4[1]; o[4 * j + 2] = t4[2]; o[4 * j + 3] = t4[3]; } }
    const bf16_t* sp = ST + ((size_t)unit * 128 + 32 * dblk + r32) * 128 + 8 * hi; const bf16_t* qp = QT + tok * D + h * 128 + 8 * hi;
#pragma unroll
    for (int d0 = 0; d0 < 8; ++d0) { const bf16x8 sf = *(const bf16x8*)(sp + 16 * d0), qfr = *(const bf16x8*)(qp + 16 * d0); o = MFMA32(sf, qfr, o); }
    float ss = 0.f;
#pragma unroll
    for (int r = 0; r < 16; ++r) ss += o[r] * o[r];
    ss += xhalf(ss);
    if (hi == 0) red[dblk * 64 + 32 * tg + r32] = ss;
    __syncthreads();
    const int t = 32 * tg + r32; const float tot = (red[t] + red[64 + t]) + (red[128 + t] + red[192 + t]);
    const float rinv = 1.f / sqrtf(tot * (1.f / 128.f) + RMS_EPS);
#pragma unroll
    for (int g = 0; g < 4; ++g) { const int v0 = 32 * dblk + 8 * g + 4 * hi; const f32x4 gn = *(const f32x4*)(onorm + h * 128 + v0);
        const u32x2 graw = *(const u32x2*)(BIG + tok * 8192 + 6144 + h * 128 + v0); const float g0 = bflo(graw.x), g1 = bfhi(graw.x), g2 = bflo(graw.y), g3 = bfhi(graw.y);
        const float y0 = o[4 * g] * rinv * gn[0] * (g0 / (1.f + __expf(-g0))), y1 = o[4 * g + 1] * rinv * gn[1] * (g1 / (1.f + __expf(-g1)));
        const float y2 = o[4 * g + 2] * rinv * gn[2] * (g2 / (1.f + __expf(-g2))), y3 = o[4 * g + 3] * rinv * gn[3] * (g3 / (1.f + __expf(-g3)));
        u32x2 w; w.x = cvtpk(y0, y1); w.y = cvtpk(y2, y3); *(u32x2*)(GO + tok * D + h * 128 + v0) = w; }
    __syncthreads();
}

#define XB_TMO      128
#define XB_XCNT(j)  (256  + 64 * (j))
#define XB_XSUB(j)  (1280 + 64 * (j))
#define XB_XGEN(j)  (2304 + 64 * (j))
#define XB_TOP      3328
#define XB_TOPGEN   3392
#define XCD_BAR_WORDS 3456
#define XB_SPIN_CAP (1u << 18)

__device__ __forceinline__ unsigned xb_ld(unsigned* p)              { return __hip_atomic_load(p, __ATOMIC_RELAXED, __HIP_MEMORY_SCOPE_AGENT); }
__device__ __forceinline__ unsigned xb_add(unsigned* p, unsigned v) { return __hip_atomic_fetch_add(p, v, __ATOMIC_RELAXED, __HIP_MEMORY_SCOPE_AGENT); }
__device__ __forceinline__ unsigned xb_xcc_id() { return (unsigned)__builtin_amdgcn_s_getreg((3 << 11) | 20) & 0xFu; }
#define XB_SPIN(cond, bar) do { unsigned _sp = 0; while (cond) { __builtin_amdgcn_s_sleep(1); \
    if ((++_sp & 255u) == 0u) { if (xb_ld(&(bar)[XB_TMO])) break; if (_sp > XB_SPIN_CAP) { atomicAdd(&(bar)[XB_TMO], 1u); break; } } } } while (0)

struct XcdBarrier {
    unsigned* bar; unsigned x;
    volatile LAS unsigned* st;
};

__device__ __forceinline__ XcdBarrier xcd_barrier_post(unsigned* bar, volatile LAS unsigned* st) {
    XcdBarrier b; b.bar = bar; b.x = xb_xcc_id(); b.st = st;
    if (threadIdx.x == 0) (void)xb_add(&bar[XB_XCNT(b.x)], 1u);
    return b;
}
__device__ __forceinline__ void xcd_barrier_complete(unsigned* bar, unsigned x, unsigned& nloc, unsigned& nx) {
    const unsigned G = gridDim.x * gridDim.y * gridDim.z;
    unsigned sum, cnt, mine, sp = 0u;
    for (;;) {
        sum = 0u; cnt = 0u; mine = 0u;
#pragma unroll
        for (unsigned j = 0; j < 16; ++j) { const unsigned c = xb_ld(&bar[XB_XCNT(j)]); sum += c; cnt += (c > 0u) ? 1u : 0u; mine = (j == x) ? c : mine; }
        if (sum == G) break;
        __builtin_amdgcn_s_sleep(1);
        if ((++sp & 255u) == 0u) { if (xb_ld(&bar[XB_TMO])) break; if (sp > XB_SPIN_CAP) { atomicAdd(&bar[XB_TMO], 1u); break; } }
    }
    nloc = mine > 0u ? mine : 1u; nx = cnt > 0u ? cnt : 1u;
}

__device__ __forceinline__ void xcd_barrier(const XcdBarrier& b) {
    asm volatile("s_waitcnt vmcnt(0)" ::: "memory");
    __syncthreads();
    if (threadIdx.x == 0) {
        unsigned* bar = b.bar;
        __builtin_amdgcn_s_waitcnt(0);
        unsigned nloc = b.st[0], nx = b.st[1];
        if (nloc == 0u) { xcd_barrier_complete(bar, b.x, nloc, nx); b.st[0] = nloc; b.st[1] = nx; }
        const unsigned old = xb_add(&bar[XB_XSUB(b.x)], 1u);
        const unsigned gen = old / nloc;
        if (old + 1u == (gen + 1u) * nloc) {
            __builtin_amdgcn_fence(__ATOMIC_RELEASE, "agent");
            asm volatile("s_waitcnt vmcnt(0)" ::: "memory");
            const unsigned og = xb_add(&bar[XB_TOP], 1u);
            const unsigned tg = og / nx;
            if (og + 1u == (tg + 1u) * nx) xb_add(&bar[XB_TOPGEN], 1u);
            else XB_SPIN(xb_ld(&bar[XB_TOPGEN]) == tg, bar);
            __builtin_amdgcn_fence(__ATOMIC_ACQUIRE, "agent");
            xb_add(&bar[XB_XGEN(b.x)], 1u);
            asm volatile("s_waitcnt vmcnt(0)" ::: "memory");
        } else {
            XB_SPIN(xb_ld(&bar[XB_XGEN(b.x)]) == gen, bar);
            __builtin_amdgcn_fence(__ATOMIC_ACQUIRE, "agent");
            asm volatile("s_waitcnt vmcnt(0)" ::: "memory");
        }
    }
    __syncthreads();
}

template <class Epi>
__device__ __forceinline__ void run_gemm(LAS unsigned char* lds, const bf16_t* A, const bf16_t* Bt, int M, int N, int K, const Epi& E, int G) {
    pg8::Gemm g{A, Bt, M, N, K}; pg8::StaticOrder S; S.init(M, N, G, (int)blockIdx.x);
    pg8::gemm_phase<Epi, pg8::StaticOrder, true, true>((PG8_LAS unsigned char*)lds, g, S, E);
}
__device__ __forceinline__ pg8::EpiStore epi_plain(bf16_t* O, int ldc, float scale = 1.f, int act = 0) {
    pg8::EpiStore e; e.O = O; e.ldc = ldc; e.scale = scale; e.act = act; e.O2 = nullptr; e.split_col = 1 << 30; e.ldc2 = 0; e.scale2 = 1.f; e.rope = nullptr; e.rope_col = 1 << 30; return e;
}

__global__ void __launch_bounds__(512) fwd_megakernel(Params p) {
    extern __shared__ __attribute__((aligned(16))) unsigned char lds_raw[];
    LAS unsigned char* lds = (LAS unsigned char*)lds_raw;
    cg::grid_group grid = cg::this_grid();
    const int G = gridDim.x, bx = blockIdx.x; const int vcu = (G % 8 == 0) ? (bx % 8) * (G / 8) + bx / 8 : bx;
    unsigned char* ws = p.ws;
    volatile LAS unsigned* bst = (volatile LAS unsigned*)(lds + LDS_BYTES - 64);
    if (threadIdx.x < 2) bst[threadIdx.x] = 0u;
    unsigned* barw = (unsigned*)ws;
    if (bx == 0) for (int i = threadIdx.x; i < XCD_BAR_WORDS; i += 512) barw[i] = 0u;
    __syncthreads();
    grid.sync();
    XcdBarrier bar = xcd_barrier_post(barw, bst);
#define PH_BEGIN {
#define PH_END   xcd_barrier(bar); }
    float* H32 = (float*)(ws + WS_H32); bf16_t* HB = (bf16_t*)(ws + WS_HB); bf16_t* BIG = (bf16_t*)(ws + WS_BIG);
    const float* ln_g = p.in[15]; const float* ln_b = p.in[16];
    bf16_t* VT = (bf16_t*)(ws + WS_VT); bf16_t* OB = (bf16_t*)(ws + WS_O);

    PH_BEGIN phase_prologue(p, lds, vcu, G); PH_END

    PH_BEGIN run_gemm(lds, HB, (const bf16_t*)(ws + WS_W_MLAIN), T, 1280, D, epi_plain((bf16_t*)(ws + WS_H0), 1280), G); PH_END
    PH_BEGIN phase_mla_prep((const bf16_t*)(ws + WS_H0), p.in[2], p.in[3], (const float*)(ws + WS_ROPE), (bf16_t*)(ws + WS_CQN), (bf16_t*)(ws + WS_CKVN), (bf16_t*)(ws + WS_KR), vcu, G); PH_END
    PH_BEGIN {
        pg8::EpiStore eq = epi_plain((bf16_t*)(ws + WS_Q3), 3072, 0.07216878364870322f * LOG2E); eq.rope = (const float*)(ws + WS_ROPE); eq.rope_col = 2048;
        run_gemm(lds, (const bf16_t*)(ws + WS_CQN), (const bf16_t*)(ws + WS_W_UQ), T, 3072, 512, eq, G);
        run_gemm(lds, (const bf16_t*)(ws + WS_CKVN), (const bf16_t*)(ws + WS_W_UK), T, 2048, 512, epi_plain((bf16_t*)(ws + WS_KN), 2048), G);
        run_gemm(lds, (const bf16_t*)(ws + WS_W_UV), (const bf16_t*)(ws + WS_CKVN), 2048, T, 512, epi_plain(VT, T), G);
    } PH_END
    PH_BEGIN { AttnArgs a{(const bf16_t*)(ws + WS_Q3), 3072, (const bf16_t*)(ws + WS_KN), (const bf16_t*)(ws + WS_KR), VT, OB, nullptr}; phase_attn<0>(lds, a, vcu, G); } PH_END
    PH_BEGIN { pg8::EpiRes e{p.in[0], H32, D, ALPHA}; run_gemm(lds, OB, (const bf16_t*)(ws + WS_W_MLAO), T, D, D, e, G); } PH_END

#define MLP_BLOCK(L, OUT32, OUTB) \
    PH_BEGIN phase_ln(H32, ln_g + ((L) * 2 + 0) * D, ln_b + ((L) * 2 + 0) * D, H32, HB, vcu, G); PH_END \
    PH_BEGIN run_gemm(lds, HB, (const bf16_t*)(ws + WS_W1) + (size_t)(L) * D * FF, T, FF, D, epi_plain(BIG, FF, 1.f, 1), G); PH_END \
    PH_BEGIN { pg8::EpiRes e{H32, H32, D, ALPHA}; run_gemm(lds, BIG, (const bf16_t*)(ws + WS_W2) + (size_t)(L) * D * FF, T, D, FF, e, G); } PH_END \
    PH_BEGIN phase_ln(H32, ln_g + ((L) * 2 + 1) * D, ln_b + ((L) * 2 + 1) * D, (OUT32), (OUTB), vcu, G); PH_END

    MLP_BLOCK(0, H32, HB)

    PH_BEGIN run_gemm(lds, HB, (const bf16_t*)(ws + WS_W_HGIN), T, 8192, D, epi_plain(BIG, 8192), G); PH_END
    PH_BEGIN for (int u = vcu; u < 2048; u += G) hgrn_h1_unit(lds, BIG, (const float*)(ws + WS_LB), (bf16_t*)(ws + WS_QT), (float*)(ws + WS_OI), (bf16_t*)(ws + WS_DELTA), (float*)(ws + WS_DEC), u); PH_END
    PH_BEGIN phase_hgrn_scan((bf16_t*)(ws + WS_DELTA), (const float*)(ws + WS_DEC), vcu, G); PH_END
    PH_BEGIN for (int u = vcu; u < 2048; u += G) hgrn_h3_unit(lds, BIG, (const bf16_t*)(ws + WS_QT), (const float*)(ws + WS_OI), (const bf16_t*)(ws + WS_DELTA), p.in[9], (bf16_t*)(ws + WS_GO), u); PH_END
    PH_BEGIN { pg8::EpiRes e{H32, H32, D, ALPHA}; run_gemm(lds, (const bf16_t*)(ws + WS_GO), (const bf16_t*)(ws + WS_W_HGO), T, D, D, e, G); } PH_END
    MLP_BLOCK(1, H32, HB)

    PH_BEGIN {
        pg8::EpiStore eq = epi_plain((bf16_t*)(ws + WS_Q), 2048, 0.08838834764831845f * LOG2E); eq.O2 = (bf16_t*)(ws + WS_K); eq.split_col = 2048; eq.ldc2 = 2048; eq.scale2 = 1.f;
        run_gemm(lds, HB, (const bf16_t*)(ws + WS_W_SBIN), T, 4096, D, eq, G);
        run_gemm(lds, (const bf16_t*)(ws + WS_W_SBIN) + (size_t)4096 * D, HB, 2048, T, D, epi_plain(VT, T), G);
    } PH_END
    PH_BEGIN { AttnArgs a{(const bf16_t*)(ws + WS_Q), 2048, (const bf16_t*)(ws + WS_K), nullptr, VT, OB, nullptr}; phase_attn<1>(lds, a, vcu, G); } PH_END
    PH_BEGIN { pg8::EpiRes e{H32, H32, D, ALPHA}; run_gemm(lds, OB, (const bf16_t*)(ws + WS_W_SBO), T, D, D, e, G); } PH_END
    MLP_BLOCK(2, H32, HB)

    PH_BEGIN {
        pg8::EpiStore eq = epi_plain((bf16_t*)(ws + WS_Q), 2048, 0.08838834764831845f * LOG2E); eq.O2 = (bf16_t*)(ws + WS_K); eq.split_col = 2048; eq.ldc2 = 2048; eq.scale2 = 1.f;
        run_gemm(lds, HB, (const bf16_t*)(ws + WS_W_MBIN), T, 4096, D, eq, G);
        run_gemm(lds, (const bf16_t*)(ws + WS_W_MBIN) + (size_t)4096 * D, HB, 2048, T, D, epi_plain(VT, T), G);
    } PH_END
    PH_BEGIN phase_kmean((const bf16_t*)(ws + WS_K), (float*)(ws + WS_KMEAN), lds, vcu, G); PH_END
    PH_BEGIN { AttnArgs a{(const bf16_t*)(ws + WS_Q), 2048, (const bf16_t*)(ws + WS_K), nullptr, VT, OB, (const float*)(ws + WS_KMEAN)}; phase_attn<2>(lds, a, vcu, G); } PH_END
    PH_BEGIN { pg8::EpiRes e{H32, H32, D, ALPHA}; run_gemm(lds, OB, (const bf16_t*)(ws + WS_W_MBO), T, D, D, e, G); } PH_END
    MLP_BLOCK(3, p.out, (bf16_t*)nullptr)
#undef PH_BEGIN
#undef PH_END
}

extern "C" void kernel_launch(void* const* d_in, const int* in_sizes, int n_in, void* d_out, int out_size, void* d_ws, size_t ws_size, hipStream_t stream) {
    static int grid = 0;
    if (grid == 0) {
        if (n_in != 19 || out_size != T * D || ws_size < WS_END) { fprintf(stderr, "kernel_launch: unexpected problem shape (n_in %d out %d ws %zu)\n", n_in, out_size, ws_size); grid = -1; return; }
        int dev = 0, cus = 0, per_cu = 0;
        (void)hipGetDevice(&dev); (void)hipDeviceGetAttribute(&cus, hipDeviceAttributeMultiprocessorCount, dev);
        if (hipFuncSetAttribute((const void*)fwd_megakernel, hipFuncAttributeMaxDynamicSharedMemorySize, LDS_BYTES) != hipSuccess) { fprintf(stderr, "kernel_launch: hipFuncSetAttribute failed\n"); grid = -1; return; }
        if (hipOccupancyMaxActiveBlocksPerMultiprocessor(&per_cu, (const void*)fwd_megakernel, 512, LDS_BYTES) != hipSuccess || per_cu < 1) { fprintf(stderr, "kernel_launch: occupancy query says %d\n", per_cu); per_cu = 1; }
        (void)hipGetLastError();
        grid = cus;
    }
    if (grid < 0) return;
    Params p{};
    for (int i = 0; i < 19; ++i) p.in[i] = (const float*)d_in[i];
    p.out = (float*)d_out; p.ws = (unsigned char*)d_ws; p.ph_lo = 0; p.ph_hi = 1 << 20;
    void* args[] = {&p};
    hipError_t e = hipLaunchCooperativeKernel((const void*)fwd_megakernel, dim3(grid), dim3(512), args, LDS_BYTES, stream);
    if (e != hipSuccess) fprintf(stderr, "kernel_launch: cooperative launch failed: %s (grid %d)\n", hipGetErrorString(e), grid);
}
```
